# Optimizing an MI355X kernel written in HIP

```python
import math
import jax, jax.numpy as jnp
from jax import lax
import numpy as np

D_MODEL = 1024
BATCH = 32
SEQ = 256
DEPTH = 4
DEC_BATCH = 2
DEC_SEQ = 4096
PAST_LEN = 512

GRID_W = 64
N_MIXERS = 2
N_MLA = (DEPTH + 1) // 2
N_FOURIER = DEPTH // 2
N_HEADS = 8
QK_NOPE = 128
QK_ROPE = 64
V_DIM = 128
Q_LORA = 512
KV_LORA = 256
AXIS_FREQS = QK_ROPE // 4
ROPE_THETA = 10000.0
N_FGROUPS = 4
FGROUP_DIM = D_MODEL // N_FGROUPS
D_FF = 2816
N_MOD = 9
Q_BLOCK = 128
EPS = 1e-6
ATTN_SCALE = 1.0 / math.sqrt(QK_NOPE + QK_ROPE)

kernel_name = "mla_fnet_macaron_dit_step"


def _rms(x, g):
    xf = x.astype(jnp.float32)
    y = xf * lax.rsqrt(jnp.mean(xf * xf, axis=-1, keepdims=True) + EPS)
    return (y * g.astype(jnp.float32)).astype(x.dtype)


def _modulate(h, shift, scale):
    return h * (1 + scale) + shift


def _modulation(cond, w, b):
    m = jax.nn.silu(cond) @ w + b
    return jnp.split(m, N_MOD, axis=-1)


def _swiglu(h, wg, wu, wd):
    return (jax.nn.silu(h @ wg) * (h @ wu)) @ wd


def _axial_rope_tables(n):
    rows = n // GRID_W
    row = jnp.repeat(jnp.arange(rows, dtype=jnp.float32), GRID_W)
    col = jnp.tile(jnp.arange(GRID_W, dtype=jnp.float32), rows)
    inv = 1.0 / (ROPE_THETA ** (jnp.arange(AXIS_FREQS, dtype=jnp.float32) / AXIS_FREQS))
    ang = jnp.stack([row[:, None] * inv, col[:, None] * inv], axis=1)
    return jnp.cos(ang), jnp.sin(ang)


def _apply_axial_rope(x, cos, sin):
    xs = x.astype(jnp.float32).reshape(x.shape[:-1] + (2, 2, AXIS_FREQS))
    x1 = xs[..., 0, :]
    x2 = xs[..., 1, :]
    c = cos[:, None]
    s = sin[:, None]
    out = jnp.stack([x1 * c - x2 * s, x2 * c + x1 * s], axis=-2)
    return out.reshape(x.shape).astype(x.dtype)


def _mla_qkv(h, w_dq, q_norm, w_uq, w_dkv, kv_norm, rope):
    B, S, _ = h.shape
    cq = _rms(h @ w_dq, q_norm)
    q = (cq @ w_uq).reshape(B, S, N_HEADS, QK_NOPE + QK_ROPE)
    kv = h @ w_dkv
    ckv = _rms(kv[..., :KV_LORA], kv_norm)
    kpe = kv[..., KV_LORA:]
    if rope is not None:
        cos, sin = rope
        q = jnp.concatenate([q[..., :QK_NOPE], _apply_axial_rope(q[..., QK_NOPE:], cos, sin)], axis=-1)
        kpe = _apply_axial_rope(kpe[:, :, None, :], cos, sin)[:, :, 0, :]
    return q, ckv, kpe


def _mla_up(ckv, kpe, w_ukv):
    B, T, _ = ckv.shape
    kvu = (ckv @ w_ukv).reshape(B, T, N_HEADS, QK_NOPE + V_DIM)
    k = jnp.concatenate(
        [kvu[..., :QK_NOPE], jnp.broadcast_to(kpe[:, :, None, :], (B, T, N_HEADS, QK_ROPE))], axis=-1)
    return k, kvu[..., QK_NOPE:]


def _attend(q, k, v):
    B, S, H, Dk = q.shape
    qb = Q_BLOCK if S % Q_BLOCK == 0 else S
    nb = S // qb
    kf = k.astype(jnp.float32)
    vf = v.astype(jnp.float32)
    qs = q.reshape(B, nb, qb, H, Dk).transpose(1, 0, 2, 3, 4)

    def block(qi):
        s = jnp.einsum('bqhd,bkhd->bhqk', qi.astype(jnp.float32), kf) * ATTN_SCALE
        p = jax.nn.softmax(s, axis=-1)
        return jnp.einsum('bhqk,bkhd->bqhd', p, vf).astype(q.dtype)

    o = lax.map(block, qs)
    return o.transpose(1, 0, 2, 3, 4).reshape(B, S, H * v.shape[-1])


def _fourier(h, w, b):
    B, S, D = h.shape
    hg = h.astype(jnp.float32).reshape(B, S, N_FGROUPS, FGROUP_DIM)
    f = jnp.fft.fft2(hg, axes=(1, 3), norm="ortho").real
    return f.reshape(B, S, D).astype(h.dtype) @ w + b


def setup_inputs(seed: int = 0) -> dict:
    key = jax.random.key(seed)
    ks = jax.random.split(key, 24)
    f32 = jnp.float32
    D = D_MODEL
    nrm = lambda k, shape, s: (jax.random.normal(k, shape, f32) * s)
    return {
        "x_prompt": nrm(ks[0], (BATCH, SEQ, D), 1.0),
        "x_sample": nrm(ks[1], (DEC_BATCH, DEC_SEQ, D), 1.0),
        "cache_ckv": nrm(ks[2], (DEC_BATCH, N_MLA, PAST_LEN, KV_LORA), 1.0),
        "cache_kpe": nrm(ks[3], (DEC_BATCH, N_MLA, PAST_LEN, QK_ROPE), 1.0),
        "c": nrm(ks[4], (DEC_BATCH, D), 1.0),
        "c_ctx": nrm(ks[5], (D,), 1.0),
        "w_mod": nrm(ks[6], (DEPTH, D, N_MOD * D), 0.5 * D ** -0.5),
        "b_mod": nrm(ks[7], (DEPTH, N_MOD * D), 0.01),
        "norm_g": 1.0 + nrm(ks[8], (DEPTH, 3, D), 0.05),
        "ffn_wg": nrm(ks[9], (DEPTH, 2, D, D_FF), D ** -0.5),
        "ffn_wu": nrm(ks[10], (DEPTH, 2, D, D_FF), D ** -0.5),
        "ffn_wd": nrm(ks[11], (DEPTH, 2, D_FF, D), D_FF ** -0.5),
        "mla_w_dq": nrm(ks[12], (N_MLA, D, Q_LORA), D ** -0.5),
        "mla_q_norm": 1.0 + nrm(ks[13], (N_MLA, Q_LORA), 0.05),
        "mla_w_uq": nrm(ks[14], (N_MLA, Q_LORA, N_HEADS * (QK_NOPE + QK_ROPE)), Q_LORA ** -0.5),
        "mla_w_dkv": nrm(ks[15], (N_MLA, D, KV_LORA + QK_ROPE), D ** -0.5),
        "mla_kv_norm": 1.0 + nrm(ks[16], (N_MLA, KV_LORA), 0.05),
        "mla_w_ukv": nrm(ks[17], (N_MLA, KV_LORA, N_HEADS * (QK_NOPE + V_DIM)), KV_LORA ** -0.5),
        "mla_w_o": nrm(ks[18], (N_MLA, N_HEADS * V_DIM, D), (N_HEADS * V_DIM) ** -0.5),
        "fourier_w": nrm(ks[19], (N_FOURIER, D, D), D ** -0.5),
        "fourier_b": nrm(ks[20], (N_FOURIER, D), 0.01),
        "final_norm": 1.0 + nrm(ks[21], (D,), 0.05),
    }


def reference(x_prompt, x_sample, cache_ckv, cache_kpe, c, c_ctx, w_mod, b_mod, norm_g,
              ffn_wg, ffn_wu, ffn_wd, mla_w_dq, mla_q_norm, mla_w_uq, mla_w_dkv, mla_kv_norm,
              mla_w_ukv, mla_w_o, fourier_w, fourier_b, final_norm):
    yp = x_prompt
    ys = x_sample
    rope_s = _axial_rope_tables(x_sample.shape[1])
    ckv_states = []
    kpe_states = []
    for l in range(DEPTH):
        mp = _modulation(c_ctx, w_mod[l], b_mod[l])
        ms = [m[:, None, :] for m in _modulation(c, w_mod[l], b_mod[l])]

        hp = _modulate(_rms(yp, norm_g[l, 0]), mp[0], mp[1])
        hs = _modulate(_rms(ys, norm_g[l, 0]), ms[0], ms[1])
        yp = yp + 0.5 * mp[2] * _swiglu(hp, ffn_wg[l, 0], ffn_wu[l, 0], ffn_wd[l, 0])
        ys = ys + 0.5 * ms[2] * _swiglu(hs, ffn_wg[l, 0], ffn_wu[l, 0], ffn_wd[l, 0])

        hp = _modulate(_rms(yp, norm_g[l, 1]), mp[3], mp[4])
        hs = _modulate(_rms(ys, norm_g[l, 1]), ms[3], ms[4])
        j = l // N_MIXERS
        if l % N_MIXERS == 0:
            qp, ckv_p, kpe_p = _mla_qkv(hp, mla_w_dq[j], mla_q_norm[j], mla_w_uq[j],
                                        mla_w_dkv[j], mla_kv_norm[j], None)
            kp, vp = _mla_up(ckv_p, kpe_p, mla_w_ukv[j])
            op = _attend(qp, kp, vp) @ mla_w_o[j]
            ckv_states.append(ckv_p)
            kpe_states.append(kpe_p)

            qs, ckv_s, kpe_s = _mla_qkv(hs, mla_w_dq[j], mla_q_norm[j], mla_w_uq[j],
                                        mla_w_dkv[j], mla_kv_norm[j], rope_s)
            k_ctx, v_ctx = _mla_up(cache_ckv[:, j], cache_kpe[:, j], mla_w_ukv[j])
            k_lat, v_lat = _mla_up(ckv_s, kpe_s, mla_w_ukv[j])
            k_all = jnp.concatenate([k_ctx, k_lat], axis=1)
            v_all = jnp.concatenate([v_ctx, v_lat], axis=1)
            os_ = _attend(qs, k_all, v_all) @ mla_w_o[j]
        else:
            op = _fourier(hp, fourier_w[j], fourier_b[j])
            os_ = _fourier(hs, fourier_w[j], fourier_b[j])
        yp = yp + mp[5] * op
        ys = ys + ms[5] * os_

        hp = _modulate(_rms(yp, norm_g[l, 2]), mp[6], mp[7])
        hs = _modulate(_rms(ys, norm_g[l, 2]), ms[6], ms[7])
        yp = yp + 0.5 * mp[8] * _swiglu(hp, ffn_wg[l, 1], ffn_wu[l, 1], ffn_wd[l, 1])
        ys = ys + 0.5 * ms[8] * _swiglu(hs, ffn_wg[l, 1], ffn_wu[l, 1], ffn_wd[l, 1])

    y_prompt = _rms(yp, final_norm)
    y_sample = _rms(ys, final_norm)
    new_ckv = jnp.stack(ckv_states, axis=1)
    new_kpe = jnp.stack(kpe_states, axis=1)
    return (y_prompt, y_sample, new_ckv, new_kpe)
```

```cpp
#include <hip/hip_runtime.h>
#include <hip/hip_cooperative_groups.h>
#include <cstdio>
#include <cstdint>
namespace cg = cooperative_groups;

#define LAS __attribute__((address_space(3)))
typedef unsigned short bf16_t;
typedef short bf16x8 __attribute__((ext_vector_type(8)));
typedef float f32x4 __attribute__((ext_vector_type(4)));
typedef float f32x2 __attribute__((ext_vector_type(2)));
typedef float f32x16 __attribute__((ext_vector_type(16)));
typedef unsigned u32x4 __attribute__((ext_vector_type(4)));
typedef unsigned u32x2 __attribute__((ext_vector_type(2)));
typedef __bf16 bf16x2_t __attribute__((ext_vector_type(2)));
#define DI __device__ __forceinline__

constexpr int DM = 1024, NTOK = 16384, NCTX = 8192, DFF = 2816, NMODC = 9216, MODL = 3 * NMODC;
constexpr int KVROWS = 17408;
constexpr int KVB = 4608;
constexpr float EPS = 1e-6f;
constexpr float QSCALE = 0.07216878364870323f * 1.4426950408889634f;

constexpr size_t al256(size_t x) { return (x + 255) & ~(size_t)255; }
constexpr size_t WS_BAR = 0, BAR_BYTES = 16384;
constexpr size_t WS_MOD = BAR_BYTES;
constexpr size_t WS_ROPE = al256(WS_MOD + (size_t)4 * MODL * 4);
constexpr size_t WS_TAB = al256(WS_ROPE + 2048 * 4);
constexpr size_t WS_GU_T = al256(WS_TAB + 8192 * 4);
constexpr size_t WS_D_T = al256(WS_GU_T + (size_t)8 * 5632 * 1024 * 2);
constexpr size_t WS_DQKV_T = al256(WS_D_T + (size_t)8 * 1024 * 2816 * 2);
constexpr size_t WS_UQ_T = al256(WS_DQKV_T + (size_t)2 * 1024 * 1024 * 2);
constexpr size_t WS_UK_T = al256(WS_UQ_T + (size_t)2 * 1536 * 512 * 2);
constexpr size_t WS_UV_T = al256(WS_UK_T + (size_t)2 * 1024 * 256 * 2);
constexpr size_t WS_WO_T = al256(WS_UV_T + (size_t)2 * 1024 * 256 * 2);
constexpr size_t WS_FW_T = al256(WS_WO_T + (size_t)2 * 1024 * 1024 * 2);
constexpr size_t WS_H = al256(WS_FW_T + (size_t)2 * 1024 * 2048 * 2);
constexpr size_t WS_SS = al256(WS_H + (size_t)NTOK * DM * 2);
constexpr size_t WS_GS = al256(WS_SS + (size_t)12 * NTOK * 4 * 4);
constexpr size_t WS_SHWGU = al256(WS_GS + (size_t)12 * 3 * 1024 * 4);
constexpr size_t WS_SHWDQ = al256(WS_SHWGU + (size_t)8 * 3 * 5632 * 4);
constexpr size_t WS_SHC = al256(WS_SHWDQ + (size_t)2 * 3 * 1024 * 4);
constexpr size_t WS_DS = al256(WS_SHC + (size_t)2 * 3 * 4 * 512 * 4);
constexpr size_t WS_DC = al256(WS_DS + (size_t)4096 * 8192 * 2);
constexpr size_t WS_CS = al256(WS_DC + (size_t)256 * 512 * 2);
constexpr size_t WS_MIX = al256(WS_CS + (size_t)512 * 256 * 2);
constexpr size_t MX_MODPART = 0;
constexpr size_t MX_ACT = 0;
constexpr size_t MX_CQRAW = 0;
constexpr size_t MX_CQ = al256(MX_CQRAW + (size_t)NTOK * 1024 * 4);
constexpr size_t MX_CKV = al256(MX_CQ + (size_t)NTOK * 512 * 2);
constexpr size_t MX_KPE = al256(MX_CKV + (size_t)KVROWS * 256 * 2);
constexpr size_t MX_Q = al256(MX_KPE + (size_t)KVROWS * 64 * 2);
constexpr size_t MX_KN = al256(MX_Q + (size_t)NTOK * 1536 * 2);
constexpr size_t MX_VT = al256(MX_KN + (size_t)KVROWS * 1024 * 2);
constexpr size_t MX_O = al256(MX_VT + (size_t)KVROWS * 1024 * 2);
constexpr size_t MX_MLA_END = al256(MX_O + (size_t)NTOK * 1024 * 2);
constexpr size_t MX_YTL = 0;
constexpr size_t MX_YTC = al256(MX_YTL + (size_t)2 * 1024 * 8192 * 2);
constexpr size_t MX_F = al256(MX_YTC + (size_t)32 * 1024 * 512 * 2);
constexpr size_t MX_FOU_END = al256(MX_F + (size_t)NTOK * 2048 * 2);
constexpr size_t MX_SIZE = MX_MLA_END > MX_FOU_END ? MX_MLA_END : MX_FOU_END;
constexpr size_t WS_END = WS_MIX + MX_SIZE;
static_assert((size_t)NTOK * DFF * 2 <= MX_SIZE && (size_t)256 * MODL * 4 <= MX_SIZE, "mix region");

#ifndef ATT_SGB
#define ATT_SGB 1
#endif
#ifndef KROT
#define KROT 2
#endif
#ifndef REP_ATTN
#define REP_ATTN 1
#endif
#ifndef REP_NORM
#define REP_NORM 1
#endif
#ifndef REP_PRO
#define REP_PRO 1
#endif
#ifndef REP_GU
#define REP_GU 1
#endif
constexpr int LDS_MISC = 147456;
constexpr int LDS_RED = LDS_MISC + 256;
constexpr int LDS_BYTES = LDS_MISC + 256 + 4096;

struct Params {
    const float *x_prompt, *x_sample, *cache_ckv, *cache_kpe, *c, *c_ctx, *w_mod, *b_mod, *norm_g, *wg, *wu, *wd,
        *w_dq, *q_norm, *w_uq, *w_dkv, *kv_norm, *w_ukv, *w_o, *fw, *fb, *final_norm;
    float* out; unsigned char* ws;
};

DI unsigned cvtpk(float lo, float hi) { f32x2 v = {lo, hi}; bf16x2_t b = __builtin_convertvector(v, bf16x2_t); return __builtin_bit_cast(unsigned, b); }
DI float bf2f(short v) { return __uint_as_float(((unsigned)(unsigned short)v) << 16); }
DI unsigned short f2bf(float f) { return (unsigned short)(cvtpk(f, 0.f) & 0xffffu); }
DI float shx(float v, int lane, int m) { return __int_as_float(__builtin_amdgcn_ds_bpermute((lane ^ m) << 2, __float_as_int(v))); }
DI float wave_sum(float v, int lane) {
#pragma unroll
    for (int o = 1; o < 64; o <<= 1) v += shx(v, lane, o);
    return v;
}
DI float max3f(float a, float b, float c) { float r; asm("v_max3_f32 %0, %1, %2, %3" : "=v"(r) : "v"(a), "v"(b), "v"(c)); return r; }
DI float fmax2f(float a, float b) { float r; asm("v_max_f32_e32 %0, %1, %2" : "=v"(r) : "v"(a), "v"(b)); return r; }
DI float rsq_p4(const float* p) { const f32x4 v = *(const f32x4*)p; return __builtin_amdgcn_rsqf(((v[0] + v[1]) + (v[2] + v[3])) * (1.0f / 1024.0f) + EPS); }
DI float rsq_ss(float ss) { return __builtin_amdgcn_rsqf(ss * (1.0f / 1024.0f) + EPS); }
DI float silu_f(float x) { return x * __builtin_amdgcn_rcpf(1.0f + __builtin_amdgcn_exp2f(-1.4426950408889634f * x)); }
DI int sopq(int v) { asm volatile("" : "+s"(v)); return v; }
DI int opq(int v) { asm volatile("" : "+v"(v)); return v; }
#define LDS_WAIT() asm volatile("s_waitcnt lgkmcnt(0)" ::: "memory")

namespace pg8 {
constexpr int BM = 256, BK = 64, HALF = 128, HTB = HALF * BK * 2, STAGE_BYTES = 8 * HTB, NXCD = 8, WGM = 8;
DI int lds_byte(int r, int c) { const int st = (r >> 4) * 2 + (c >> 5), rr = r & 15, cc = c & 31, ob = rr * 64 + cc * 2; return st * 1024 + (ob ^ (((ob >> 9) & 1) << 5)); }
DI void stage_rc(int b, int& R, int& C) { const int st = b / 1024, sb = b % 1024, swz = sb ^ (((sb >> 9) & 1) << 5); R = (st >> 1) * 16 + swz / 64; C = (st & 1) * 32 + (swz % 64) / 2; }
DI int perm32(int rho) { const int n = rho >> 4, i = rho & 15; return 8 * (i >> 2) + 4 * n + (i & 3); }

struct Unit { int z, pm, pn; };
struct Gemm { const bf16_t* A; const bf16_t* Bt; int lda, ldb, K, nM, nN, nZ; long sAz, sBz; int zsh = 0; long sAy = 0, sBy = 0; };

struct Order {
    int nM, nMz, nN, nwg, G, c;
    DI void init(const Gemm& g, int G_, int c_) { nM = g.nM; nMz = g.nM * g.nZ; nN = g.nN; nwg = nMz * nN; G = G_; c = c_; }
    DI bool next(int i, Unit& u) const {
        const long L = (long)i * G + c; if (L >= nwg) return false;
        int wgid = (int)L; { const int q = nwg / NXCD, r = nwg % NXCD, xcd = wgid % NXCD, off = wgid / NXCD; wgid = (xcd < r ? xcd * (q + 1) : r * (q + 1) + (xcd - r) * q) + off; }
        const int nig = WGM * nN, gid = wgid / nig, fm = gid * WGM, gsz = (nMz - fm) < WGM ? (nMz - fm) : WGM;
        const int pmz = fm + ((wgid % nig) % gsz); u.pn = (wgid % nig) / gsz; u.z = pmz / nM; u.pm = pmz % nM; return true;
    }
};

typedef f32x4 Acc[2][2][4][2];

struct EpiBf16 {
    static constexpr bool PERM = true;
    bf16_t* O; long ldc; long zs; float scale; int zsh = 0; long ys = 0;
    DI void operator()(const Acc& acc, const Unit& u, int wr, int wc, int fr, int fq) const {
        bf16_t* base = O + (size_t)(u.z >> zsh) * zs + (size_t)(u.z & ((1 << zsh) - 1)) * ys + (size_t)(u.pm * BM + wr * 64 + fr) * ldc + u.pn * BM + wc * 32 + 8 * fq;
#pragma unroll
        for (int ai = 0; ai < 2; ++ai)
#pragma unroll
            for (int m = 0; m < 4; ++m) { bf16_t* rowp = base + (size_t)(ai * HALF + m * 16) * ldc;
#pragma unroll
                for (int bj = 0; bj < 2; ++bj) { const f32x4 v0 = acc[ai][bj][m][0] * scale, v1 = acc[ai][bj][m][1] * scale;
                    u32x4 w; w.x = cvtpk(v0[0], v0[1]); w.y = cvtpk(v0[2], v0[3]); w.z = cvtpk(v1[0], v1[1]); w.w = cvtpk(v1[2], v1[3]);
                    *(u32x4*)(rowp + bj * HALF) = w; } }
    }
};
struct EpiYt {
    static constexpr bool PERM = true;
    bf16_t* YtC; bf16_t* YtL; const float* SSp; const float* shc;
    DI void operator()(const Acc& acc, const Unit& u, int wr, int wc, int fr, int fq) const {
        bf16_t* tb; long ldc;
        if (u.pn < 32) { tb = YtC + (size_t)u.pn * 1024 * 512 + (size_t)(u.z * 256) * 512 + u.pm * 256; ldc = 512; }
        else { const int t = (u.pn - 32) * 256, b = t >> 12, s0 = t & 4095; tb = YtL + (size_t)b * 1024 * 8192 + (size_t)(u.z * 256) * 8192 + u.pm * 4096 + s0; ldc = 8192; }
        const int tok0 = u.pn * BM; const int cond = tok0 >= NCTX ? 1 + ((tok0 - NCTX) >> 12) : 0;
        const float* sc = shc + (cond * 4 + u.z) * 512 + u.pm * 256 + wr * 64 + fr;
        f32x4 rsv[2][2];
#pragma unroll
        for (int bj = 0; bj < 2; ++bj)
#pragma unroll
            for (int n = 0; n < 2; ++n) { const float* sp = SSp + (size_t)(tok0 + bj * HALF + wc * 32 + 8 * fq + 4 * n) * 4; rsv[bj][n] = (f32x4){rsq_p4(sp), rsq_p4(sp + 4), rsq_p4(sp + 8), rsq_p4(sp + 12)}; }
        bf16_t* base = tb + (size_t)(wr * 64 + fr) * ldc + wc * 32 + 8 * fq;
#pragma unroll
        for (int ai = 0; ai < 2; ++ai)
#pragma unroll
            for (int m = 0; m < 4; ++m) { bf16_t* rowp = base + (size_t)(ai * HALF + m * 16) * ldc; const float sh = sc[ai * HALF + m * 16];
#pragma unroll
                for (int bj = 0; bj < 2; ++bj) { const f32x4 v0 = acc[ai][bj][m][0] * rsv[bj][0] + sh, v1 = acc[ai][bj][m][1] * rsv[bj][1] + sh;
                    u32x4 w; w.x = cvtpk(v0[0], v0[1]); w.y = cvtpk(v0[2], v0[3]); w.z = cvtpk(v1[0], v1[1]); w.w = cvtpk(v1[2], v1[3]);
                    *(u32x4*)(rowp + bj * HALF) = w; } }
    }
};
struct EpiSwiglu {
    static constexpr bool PERM = true;
    bf16_t* O; const float* SSp; const float* shw;
    DI void operator()(const Acc& acc, const Unit& u, int wr, int wc, int fr, int fq) const {
        const int rowt = u.pm * BM; const int cond = rowt >= NCTX ? 1 + ((rowt - NCTX) >> 12) : 0;
        const float* sw = shw + cond * 5632 + u.pn * BM + wc * 32 + 8 * fq;
        const f32x4 sg0 = *(const f32x4*)sw, sg1 = *(const f32x4*)(sw + 4), su0 = *(const f32x4*)(sw + HALF), su1 = *(const f32x4*)(sw + HALF + 4);
        const float* ssr = SSp + (size_t)(rowt + wr * 64 + fr) * 4;
        bf16_t* base = O + (size_t)(u.pm * BM + wr * 64 + fr) * DFF + u.pn * HALF + wc * 32 + 8 * fq;
#pragma unroll
        for (int ai = 0; ai < 2; ++ai)
#pragma unroll
            for (int m = 0; m < 4; ++m) { bf16_t* rowp = base + (size_t)(ai * HALF + m * 16) * DFF; const float rs = rsq_p4(ssr + (ai * HALF + m * 16) * 4);
                const f32x4 g0 = acc[ai][0][m][0] * rs + sg0, g1 = acc[ai][0][m][1] * rs + sg1, u0 = acc[ai][1][m][0] * rs + su0, u1 = acc[ai][1][m][1] * rs + su1;
                float v[8];
#pragma unroll
                for (int j = 0; j < 4; ++j) { v[j] = silu_f(g0[j]) * u0[j]; v[4 + j] = silu_f(g1[j]) * u1[j]; }
                u32x4 w; w.x = cvtpk(v[0], v[1]); w.y = cvtpk(v[2], v[3]); w.z = cvtpk(v[4], v[5]); w.w = cvtpk(v[6], v[7]);
                *(u32x4*)rowp = w; }
    }
};
struct EpiF32 {
    static constexpr bool PERM = false;
    float* O; const float* SSp; const float* shw;
    DI void operator()(const Acc& acc, const Unit& u, int wr, int wc, int fr, int fq) const {
        const int rowt = u.pm * BM; const int cond = rowt >= NCTX ? 1 + ((rowt - NCTX) >> 12) : 0;
        const float* sw = shw + cond * 1024 + u.pn * BM + wc * 32 + 4 * fq;
        f32x4 sv[2][2];
#pragma unroll
        for (int bj = 0; bj < 2; ++bj)
#pragma unroll
            for (int n = 0; n < 2; ++n) sv[bj][n] = *(const f32x4*)(sw + bj * HALF + n * 16);
        const float* ssr = SSp + (size_t)(rowt + wr * 64 + fr) * 4;
        float* base = O + (size_t)(u.pm * BM + wr * 64 + fr) * 1024 + u.pn * BM + wc * 32 + 4 * fq;
#pragma unroll
        for (int ai = 0; ai < 2; ++ai)
#pragma unroll
            for (int m = 0; m < 4; ++m) { float* rowp = base + (size_t)(ai * HALF + m * 16) * 1024; const float rs = rsq_p4(ssr + (ai * HALF + m * 16) * 4);
#pragma unroll
                for (int bj = 0; bj < 2; ++bj)
#pragma unroll
                    for (int n = 0; n < 2; ++n) *(f32x4*)(rowp + bj * HALF + n * 16) = acc[ai][bj][m][n] * rs + sv[bj][n]; }
    }
};
struct EpiResid {
    static constexpr bool PERM = true;
    const float* xlo; const float* xhi; float* out; const float* coef; const float* bias; bf16_t* Hs; const float* gsn; float* ssn; LAS unsigned char* lds; float cmul; int wh_;
    DI void operator()(Acc& acc, const Unit& u, int wr, int wc, int fr, int fq) const {
        const int rowt = u.pm * BM; const bool hi = rowt >= NCTX;
        const int cond = hi ? 1 + ((rowt - NCTX) >> 12) : 0;
        const float* cf = coef + cond * NMODC;
        const float* xb = hi ? xhi + (size_t)(rowt - NCTX) * 1024 : xlo + (size_t)rowt * 1024;
        float* ob = out + (size_t)rowt * 1024;
        const int col0 = u.pn * BM + wc * 32 + 8 * fq;
        const bool wh = wh_ != 0;
        LAS float* red = (LAS float*)(lds + LDS_RED);
        if (bias) {
#pragma unroll
            for (int bj = 0; bj < 2; ++bj)
#pragma unroll
                for (int n = 0; n < 2; ++n) { const f32x4 b4 = *(const f32x4*)(bias + col0 + bj * HALF + n * 4);
#pragma unroll
                    for (int ai = 0; ai < 2; ++ai)
#pragma unroll
                        for (int m = 0; m < 4; ++m) acc[ai][bj][m][n] += b4; }
        }
        f32x4 cv[2][2], gv[2][2];
#pragma unroll
        for (int bj = 0; bj < 2; ++bj)
#pragma unroll
            for (int n = 0; n < 2; ++n) { const int cc = col0 + bj * HALF + n * 4; cv[bj][n] = *(const f32x4*)(cf + cc) * cmul;
                gv[bj][n] = wh ? *(const f32x4*)(gsn + cond * 1024 + cc) : (f32x4){0.f, 0.f, 0.f, 0.f}; }
#pragma unroll
        for (int ai = 0; ai < 2; ++ai)
#pragma unroll
            for (int m = 0; m < 4; ++m) { const int rl = ai * HALF + wr * 64 + m * 16 + fr; const size_t roff = (size_t)rl * 1024 + col0; float sq = 0.f;
#pragma unroll
                for (int bj = 0; bj < 2; ++bj) { const size_t off = roff + bj * HALF;
                    const f32x4 x0 = *(const f32x4*)(xb + off), x1 = *(const f32x4*)(xb + off + 4);
                    const f32x4 o0 = x0 + cv[bj][0] * acc[ai][bj][m][0], o1 = x1 + cv[bj][1] * acc[ai][bj][m][1];
                    *(f32x4*)(ob + off) = o0; *(f32x4*)(ob + off + 4) = o1;
                    if (wh) { sq += ((o0[0] * o0[0] + o0[1] * o0[1]) + (o0[2] * o0[2] + o0[3] * o0[3])) + ((o1[0] * o1[0] + o1[1] * o1[1]) + (o1[2] * o1[2] + o1[3] * o1[3]));
                        const f32x4 h0 = o0 * gv[bj][0], h1 = o1 * gv[bj][1];
                        u32x4 w; w.x = cvtpk(h0[0], h0[1]); w.y = cvtpk(h0[2], h0[3]); w.z = cvtpk(h1[0], h1[1]); w.w = cvtpk(h1[2], h1[3]);
                        *(u32x4*)(Hs + (size_t)rowt * 1024 + off) = w; } }
                if (wh) { const int ln = fq * 16 + fr; sq += shx(sq, ln, 16); sq += shx(sq, ln, 32); if (fq == 0) red[rl * 4 + wc] = sq; } }
        if (wh) {
            asm volatile("s_waitcnt lgkmcnt(0)" ::: "memory"); __builtin_amdgcn_s_barrier(); asm volatile("" ::: "memory");
            const int t = wr * 256 + wc * 64 + fq * 16 + fr;
            if (t < 256) { const f32x4 p = *(const LAS f32x4*)(red + t * 4); ssn[(size_t)(rowt + t) * 4 + u.pn] = (p[0] + p[1]) + (p[2] + p[3]); }
        }
    }
};

template <class Epi>
DI void gemm_phase(LAS unsigned char* lds, const Gemm g, const Order& S, const Epi& E) {
    const int tid = opq(threadIdx.x), wid = __builtin_amdgcn_readfirstlane(tid >> 6), lane = tid & 63, wr = wid >> 2, wc = wid & 3, fr = lane & 15, fq = lane >> 4;
    const int K = g.K, nt = K / BK;
    unsigned voffA[2], voffB[2];
#pragma unroll
    for (int i = 0; i < 2; ++i) { int R, C; stage_rc(tid * 16 + i * 8192, R, C); const int Rb = Epi::PERM ? ((R & ~31) + perm32(R & 31)) : R;
        voffA[i] = (unsigned)(R * g.lda + C) * 2u; voffB[i] = (unsigned)(Rb * g.ldb + C) * 2u; }
    const size_t kstep = (size_t)(BK * 2);
    const size_t hstepA = (size_t)HALF * g.lda * 2, hstepB = (size_t)HALF * g.ldb * 2;
    const unsigned ldsw = (unsigned)wid * 1024u;
    const int aoff = lds_byte(wr * 64 + fr, fq * 8), boff = lds_byte(wc * 32 + fr, fq * 8);
#define PG8_UA(u) ((const char*)g.A + ((size_t)((u).z >> g.zsh) * g.sAz + (size_t)((u).z & ((1 << g.zsh) - 1)) * g.sAy + (size_t)(u).pm * BM * g.lda) * 2)
#define PG8_UB(u) ((const char*)g.Bt + ((size_t)((u).z >> g.zsh) * g.sBz + (size_t)((u).z & ((1 << g.zsh) - 1)) * g.sBy + (size_t)(u).pn * BM * g.ldb) * 2)
#define PG8_SA(b, h) (((b) * 2 + (h)) * HTB)
#define PG8_SB(b, h) ((4 + (b) * 2 + (h)) * HTB)
#define PG8_STAGE(bufoff, gbase, voff) do { _Pragma("unroll") for (int _i = 0; _i < 2; ++_i) \
        __builtin_amdgcn_global_load_lds((const unsigned*)((const char*)(gbase) + (voff)[_i]), (LAS unsigned*)(lds + (bufoff) + ldsw + _i * 8192), 16, 0, 0); } while (0)
#define PG8_LDA(dst, b, h) do { _Pragma("unroll") for (int m = 0; m < 4; ++m) _Pragma("unroll") for (int k = 0; k < 2; ++k) dst[m][k] = *(const LAS bf16x8*)(lds + PG8_SA(b, h) + aoff + m * 2048 + k * 1024); } while (0)
#define PG8_LDB(dst, b, h) do { _Pragma("unroll") for (int n = 0; n < 2; ++n) _Pragma("unroll") for (int k = 0; k < 2; ++k) dst[n][k] = *(const LAS bf16x8*)(lds + PG8_SB(b, h) + boff + n * 2048 + k * 1024); } while (0)
#define PG8_MMA(ai, bj, At, Bt) do { __builtin_amdgcn_s_setprio(1); _Pragma("unroll") for (int m = 0; m < 4; ++m) _Pragma("unroll") for (int n = 0; n < 2; ++n) _Pragma("unroll") for (int k = 0; k < 2; ++k) \
        acc[ai][bj][m][n] = __builtin_amdgcn_mfma_f32_16x16x32_bf16(Bt[n][k], At[m][k], acc[ai][bj][m][n], 0, 0, 0); __builtin_amdgcn_s_setprio(0); } while (0)
#define PG8_WAIT_V(n) asm volatile("s_waitcnt vmcnt(" #n ")" ::: "memory")
#define PG8_WAIT_L(n) asm volatile("s_waitcnt lgkmcnt(" #n ")" ::: "memory")
#define PG8_BAR __builtin_amdgcn_s_barrier()
#define PG8_SCHED __builtin_amdgcn_sched_barrier(0)
    Unit cur, nxt; int ui = 0;
    if (!S.next(0, cur)) return;
    Acc acc;
#pragma unroll
    for (int a = 0; a < 2; ++a)
#pragma unroll
        for (int b = 0; b < 2; ++b)
#pragma unroll
            for (int m = 0; m < 4; ++m)
#pragma unroll
                for (int n = 0; n < 2; ++n) acc[a][b][m][n] = (f32x4){0.f, 0.f, 0.f, 0.f};
    bf16x8 At[4][2], B0[2][2], B1[2][2];
#define PG8_KOFF(u) ((KROT * (((u).pm + (u).pn) & 7)) % nt)
    int koff = PG8_KOFF(cur);
    const char* cA = PG8_UA(cur); const char* cB = PG8_UB(cur);
    { const char* pA = cA + (size_t)koff * kstep; const char* pB = cB + (size_t)koff * kstep;
    PG8_STAGE(PG8_SB(0, 0), pB, voffB); PG8_STAGE(PG8_SB(0, 1), pB + hstepB, voffB); PG8_STAGE(PG8_SA(0, 0), pA, voffA); PG8_STAGE(PG8_SA(0, 1), pA + hstepA, voffA);
    if (wr == 1) PG8_BAR;
    PG8_WAIT_V(2); PG8_BAR;
    PG8_STAGE(PG8_SB(1, 0), pB + kstep, voffB); PG8_STAGE(PG8_SA(1, 0), pA + kstep, voffA); PG8_STAGE(PG8_SB(1, 1), pB + hstepB + kstep, voffB);
    PG8_WAIT_V(6); PG8_BAR; }
    for (;;) {
        const bool has_next = S.next(ui + 1, nxt);
        const char* nA = has_next ? PG8_UA(nxt) : cA; const char* nB = has_next ? PG8_UB(nxt) : cB;
        const int noff = has_next ? PG8_KOFF(nxt) : koff;
        int kp = koff;
        for (int t = 0; t < nt; t += 2) {
            const bool last = (t == nt - 2);
            int kp2 = kp + 2; if (kp2 >= nt) kp2 -= nt;
            const char* a1 = cA + (size_t)(kp + 1) * kstep;
            const char* a2 = last ? nA + (size_t)noff * kstep : cA + (size_t)kp2 * kstep; const char* b2 = last ? nB + (size_t)noff * kstep : cB + (size_t)kp2 * kstep;
            kp = kp2;
            const char* a3 = a2 + kstep; const char* b3 = b2 + kstep;
            PG8_LDB(B0, 0, 0); PG8_LDB(B1, 0, 1); PG8_SCHED; PG8_LDA(At, 0, 0); PG8_STAGE(PG8_SA(1, 1), a1 + hstepA, voffA);
            PG8_WAIT_V(8); PG8_WAIT_L(0); PG8_BAR; PG8_MMA(0, 0, At, B0); PG8_MMA(0, 1, At, B1); PG8_BAR; PG8_SCHED;
            PG8_LDA(At, 0, 1); PG8_STAGE(PG8_SB(0, 0), b2, voffB); PG8_STAGE(PG8_SB(0, 1), b2 + hstepB, voffB); PG8_STAGE(PG8_SA(0, 0), a2, voffA);
            PG8_WAIT_V(8); PG8_WAIT_L(0); PG8_BAR; PG8_MMA(1, 0, At, B0); PG8_MMA(1, 1, At, B1); PG8_BAR; PG8_SCHED;
            PG8_LDB(B0, 1, 0); PG8_LDB(B1, 1, 1); PG8_SCHED; PG8_LDA(At, 1, 0); PG8_STAGE(PG8_SA(0, 1), a2 + hstepA, voffA);
            PG8_WAIT_V(8); PG8_WAIT_L(0); PG8_BAR; PG8_MMA(0, 0, At, B0); PG8_MMA(0, 1, At, B1); PG8_BAR; PG8_SCHED;
            PG8_LDA(At, 1, 1); PG8_STAGE(PG8_SB(1, 0), b3, voffB); PG8_STAGE(PG8_SB(1, 1), b3 + hstepB, voffB); PG8_STAGE(PG8_SA(1, 0), a3, voffA);
            PG8_WAIT_V(8); PG8_WAIT_L(0); PG8_BAR; PG8_MMA(1, 0, At, B0); PG8_MMA(1, 1, At, B1); PG8_BAR; PG8_SCHED;
        }
        if (wr == 0) PG8_BAR;
        E(acc, cur, wr, wc, fr, fq);
        if (!has_next) break;
#pragma unroll
        for (int a = 0; a < 2; ++a)
#pragma unroll
            for (int b = 0; b < 2; ++b)
#pragma unroll
                for (int m = 0; m < 4; ++m)
#pragma unroll
                    for (int n = 0; n < 2; ++n) acc[a][b][m][n] = (f32x4){0.f, 0.f, 0.f, 0.f};
        cur = nxt; cA = nA; cB = nB; koff = noff; ++ui;
        if (wr == 1) PG8_BAR;
    }
    PG8_WAIT_V(0);
    PG8_BAR;
#undef PG8_KOFF
#undef PG8_UA
#undef PG8_UB
#undef PG8_SA
#undef PG8_SB
#undef PG8_STAGE
#undef PG8_LDA
#undef PG8_LDB
#undef PG8_MMA
#undef PG8_WAIT_V
#undef PG8_WAIT_L
#undef PG8_BAR
#undef PG8_SCHED
}
}

struct AttnT { const bf16_t* Q; const bf16_t* KN; const bf16_t* KPE; const bf16_t* VT; bf16_t* O; const float* rope; };
constexpr int AK_ROW = 384, AK_BUF = 64 * AK_ROW, AV_ROW = 128, AV_BUF = 128 * AV_ROW, AV_OFF = 4 * AK_BUF;
static_assert(AV_OFF + 3 * AV_BUF <= LDS_MISC, "attention LDS");

DI void attn_unit(LAS unsigned char* lds, const AttnT& T, int qrow0, int h, int kv0, int nk, int pos0, bool rope) {
    const int tid = opq(threadIdx.x), lane = tid & 63, wid = tid >> 6, r = lane & 31, h2 = lane >> 5;
    const int pr = (r & ~12) | ((r & 4) << 1) | ((r & 8) >> 1);
    bf16x8 qf[12];
    { const bf16_t* qp = T.Q + (size_t)(qrow0 + 32 * wid + r) * 1536 + h * 192 + 8 * h2;
#pragma unroll
      for (int ks = 0; ks < 12; ++ks) qf[ks] = *(const bf16x8*)(qp + 16 * ks); }
    if (rope) {
        const int pos = pos0 + 32 * wid + r;
#pragma unroll
        for (int a = 0; a < 2; ++a) {
            const int idx = a ? (pos & 63) : (pos >> 6);
            const float* cs = T.rope + idx * 16 + 8 * h2;
            const f32x4 c0 = *(const f32x4*)cs, c1 = *(const f32x4*)(cs + 4), s0 = *(const f32x4*)(cs + 1024), s1 = *(const f32x4*)(cs + 1028);
            bf16x8 x1 = qf[8 + 2 * a], x2 = qf[9 + 2 * a], o1, o2;
#pragma unroll
            for (int j = 0; j < 8; ++j) { const float cc = j < 4 ? c0[j & 3] : c1[j & 3], sn = j < 4 ? s0[j & 3] : s1[j & 3];
                const float a1 = bf2f(x1[j]), a2 = bf2f(x2[j]);
                o1[j] = (short)f2bf(a1 * cc - a2 * sn); o2[j] = (short)f2bf(a2 * cc + a1 * sn); }
            qf[8 + 2 * a] = o1; qf[9 + 2 * a] = o2;
        }
    }
    const char* gk[3]; unsigned skb[3];
#pragma unroll
    for (int j = 0; j < 3; ++j) { const int c = (wid * 3 + j) * 64 + lane, row = c / 24, pc = c - row * 24, lc = pc ^ ((row >> 1) & 7);
        const bool nope = lc < 16;
        gk[j] = nope ? (const char*)(T.KN + (size_t)(kv0 + row) * 1024 + h * 128 + lc * 8) : (const char*)(T.KPE + (size_t)(kv0 + row) * 64 + (lc - 16) * 8);
        skb[j] = nope ? 64u * 1024u * 2u : 64u * 64u * 2u; }
    const char* gv[2];
#pragma unroll
    for (int j = 0; j < 2; ++j) { const int c = (wid * 2 + j) * 64 + lane, row = c >> 3, lc = (c & 7) ^ ((row >> 1) & 7);
        gv[j] = (const char*)(T.VT + (size_t)(h * 128 + row) * KVROWS + kv0 + lc * 8); }
    const int wid_u = __builtin_amdgcn_readfirstlane(wid);
#define ATT_DMA_K(t, slot) do { _Pragma("unroll") for (int j_ = 0; j_ < 3; ++j_) \
        __builtin_amdgcn_global_load_lds((const unsigned*)(gk[j_] + (size_t)(t) * skb[j_]), (LAS unsigned*)(lds + (slot) * AK_BUF + (wid_u * 3 + j_) * 1024), 16, 0, 0); } while (0)
#define ATT_DMA_V(t, slot) do { _Pragma("unroll") for (int j_ = 0; j_ < 2; ++j_) \
        __builtin_amdgcn_global_load_lds((const unsigned*)(gv[j_] + (size_t)(t) * 128), (LAS unsigned*)(lds + AV_OFF + (slot) * AV_BUF + (wid_u * 2 + j_) * 1024), 16, 0, 0); } while (0)
#define ATT_WAIT_V(n) asm volatile("s_waitcnt vmcnt(" #n ")" ::: "memory")
#define ATT_BAR() do { __builtin_amdgcn_s_barrier(); asm volatile("" ::: "memory"); } while (0)
    const int kswz = (pr >> 1) & 7, vswz = (r >> 1) & 7;
    int kco[4], vco[4];
#pragma unroll
    for (int j = 0; j < 4; ++j) { kco[j] = pr * AK_ROW + (((2 * j + h2) ^ kswz) << 4); vco[j] = AV_OFF + r * AV_ROW + (((2 * j + h2) ^ vswz) << 4); }
#define ATT_KF(slotbase, kb2, ks) (*(const LAS bf16x8*)((slotbase) + (kb2) * 32 * AK_ROW + kco[(ks) & 3] + ((ks) >> 2) * 128))
    f32x16 o[4];
#pragma unroll
    for (int d = 0; d < 4; ++d)
#pragma unroll
        for (int i = 0; i < 16; ++i) o[d][i] = 0.f;
    float mrun = -1e30f, lrun = 0.f;
    const int ntile = nk >> 6, tlast = ntile - 1;
    ATT_DMA_K(0, 0); ATT_DMA_V(0, 0); ATT_DMA_K(1 < tlast ? 1 : tlast, 1);
    ATT_DMA_K(2 < tlast ? 2 : tlast, 2); ATT_DMA_V(1 < tlast ? 1 : tlast, 1);
    ATT_WAIT_V(5); ATT_BAR();
    f32x16 s0, s1;
#pragma unroll
    for (int i = 0; i < 16; ++i) { s0[i] = 0.f; s1[i] = 0.f; }
    { const LAS unsigned char* kb_ = lds;
#pragma unroll
      for (int ks = 0; ks < 12; ++ks) { const bf16x8 k0_ = ATT_KF(kb_, 0, ks), k1_ = ATT_KF(kb_, 1, ks);
          s0 = __builtin_amdgcn_mfma_f32_32x32x16_bf16(k0_, qf[ks], s0, 0, 0, 0); s1 = __builtin_amdgcn_mfma_f32_32x32x16_bf16(k1_, qf[ks], s1, 0, 0, 0); } }
    int ksl = 1, vsl = 0;
    for (int t = 0; t < ntile; ++t) {
        { const int tk = t + 3 < tlast ? t + 3 : tlast, tv = t + 2 < tlast ? t + 2 : tlast;
          const int kd = (ksl + 2) & 3, vd = vsl + 2 >= 3 ? vsl - 1 : vsl + 2; ATT_DMA_K(tk, kd); ATT_DMA_V(tv, vd); }
        f32x16 n0, n1;
#pragma unroll
        for (int i = 0; i < 16; ++i) { n0[i] = 0.f; n1[i] = 0.f; }
        const LAS unsigned char* kb_ = lds + ksl * AK_BUF;
        bf16x8 ka0 = ATT_KF(kb_, 0, 0), ka1 = ATT_KF(kb_, 1, 0), kn0 = ATT_KF(kb_, 0, 1), kn1 = ATT_KF(kb_, 1, 1);
        float mx = 0.f, oth = 0.f, mnew = 0.f, alpha = 1.f, ps = 0.f;
#define SEL(e) ((e) < 16 ? s0[(e) & 15] : s1[(e) & 15])
#define PEXP(e) do { const float p_ = __builtin_amdgcn_exp2f(SEL(e) - mnew); if ((e) < 16) s0[(e) & 15] = p_; else s1[(e) & 15] = p_; ps += p_; } while (0)
#pragma unroll
        for (int ks = 0; ks < 12; ++ks) {
            bf16x8 kf0 = kn0, kf1 = kn1;
            if (ks < 10) { kf0 = ATT_KF(kb_, 0, ks + 2); kf1 = ATT_KF(kb_, 1, ks + 2); }
            n0 = __builtin_amdgcn_mfma_f32_32x32x16_bf16(ka0, qf[ks], n0, 0, 0, 0);
            n1 = __builtin_amdgcn_mfma_f32_32x32x16_bf16(ka1, qf[ks], n1, 0, 0, 0);
            if (ks == 0) { mx = max3f(s0[0], s0[1], s0[2]);
#pragma unroll
                for (int i = 3; i < 15; i += 2) mx = max3f(mx, s0[i], s0[i + 1]);
                mx = max3f(mx, s0[15], s1[0]); }
            if (ks == 1) {
#pragma unroll
                for (int i = 1; i < 15; i += 2) mx = max3f(mx, s1[i], s1[i + 1]);
                mx = fmax2f(mx, s1[15]); oth = shx(mx, lane, 32); }
            if (ks == 2) { mnew = max3f(mrun, mx, oth); alpha = __builtin_amdgcn_exp2f(mrun - mnew); mrun = mnew; PEXP(0); PEXP(1); }
            if (ks >= 3 && ks <= 9) { PEXP(2 + 4 * (ks - 3)); PEXP(3 + 4 * (ks - 3)); PEXP(4 + 4 * (ks - 3)); PEXP(5 + 4 * (ks - 3)); }
            if (ks == 10) { PEXP(30); PEXP(31); lrun = lrun * alpha + ps; }
            if (ks == 11) {
#pragma unroll
                for (int d = 0; d < 4; ++d) o[d] = o[d] * alpha; }
            __builtin_amdgcn_sched_barrier(0);
            ka0 = kn0; ka1 = kn1; kn0 = kf0; kn1 = kf1;
        }
#undef SEL
#undef PEXP
        bf16x8 pf[4];
#pragma unroll
        for (int s = 0; s < 2; ++s) {
            u32x4 p; p.x = cvtpk(s0[8 * s], s0[8 * s + 1]); p.y = cvtpk(s0[8 * s + 2], s0[8 * s + 3]); p.z = cvtpk(s0[8 * s + 4], s0[8 * s + 5]); p.w = cvtpk(s0[8 * s + 6], s0[8 * s + 7]);
            pf[s] = __builtin_bit_cast(bf16x8, p);
            u32x4 q; q.x = cvtpk(s1[8 * s], s1[8 * s + 1]); q.y = cvtpk(s1[8 * s + 2], s1[8 * s + 3]); q.z = cvtpk(s1[8 * s + 4], s1[8 * s + 5]); q.w = cvtpk(s1[8 * s + 6], s1[8 * s + 7]);
            pf[2 + s] = __builtin_bit_cast(bf16x8, q);
        }
        const LAS unsigned char* vb = lds + vsl * AV_BUF;
        bf16x8 va[4], vn[4];
#pragma unroll
        for (int d = 0; d < 4; ++d) va[d] = *(const LAS bf16x8*)(vb + d * 32 * AV_ROW + vco[0]);
#pragma unroll
        for (int j = 0; j < 4; ++j) {
#pragma unroll
            for (int d = 0; d < 4; ++d) vn[d] = (j < 3) ? *(const LAS bf16x8*)(vb + d * 32 * AV_ROW + vco[(j + 1) & 3]) : va[d];
#pragma unroll
            for (int d = 0; d < 4; ++d) o[d] = __builtin_amdgcn_mfma_f32_32x32x16_bf16(va[d], pf[j], o[d], 0, 0, 0);
            __builtin_amdgcn_sched_barrier(0);
#pragma unroll
            for (int d = 0; d < 4; ++d) va[d] = vn[d];
        }
        asm volatile("s_waitcnt lgkmcnt(0)" ::: "memory"); ATT_WAIT_V(5); ATT_BAR();
        s0 = n0; s1 = n1;
        ksl = (ksl + 1) & 3; vsl = vsl + 1 >= 3 ? 0 : vsl + 1;
    }
    ATT_WAIT_V(0); ATT_BAR();
    const float ltot = lrun + shx(lrun, lane, 32);
    const float inv = 1.0f / ltot;
    bf16_t* op = T.O + (size_t)(qrow0 + 32 * wid + r) * 1024 + h * 128 + 4 * h2;
#pragma unroll
    for (int d = 0; d < 4; ++d)
#pragma unroll
        for (int gq = 0; gq < 4; ++gq) {
            u32x2 w; w.x = cvtpk(o[d][4 * gq] * inv, o[d][4 * gq + 1] * inv); w.y = cvtpk(o[d][4 * gq + 2] * inv, o[d][4 * gq + 3] * inv);
            *(u32x2*)(op + 32 * d + 8 * gq) = w;
        }
#undef ATT_DMA_K
#undef ATT_DMA_V
#undef ATT_WAIT_V
#undef ATT_BAR
#undef ATT_KF
}

DI void transpose_item(const float* W, int N, bf16_t* WT, int ldt, int dst_row0, LAS float* scr, int k0, int n0, int lane_) {
    const int lane = opq(lane_);
    f32x4 v[8];
    const float* wp = W + (size_t)(k0 + (lane >> 3)) * N + n0 + (lane & 7) * 4;
#pragma unroll
    for (int i = 0; i < 8; ++i) v[i] = __builtin_nontemporal_load((const f32x4*)(wp + (size_t)(8 * i) * N));
#pragma unroll
    for (int i = 0; i < 8; ++i) { LAS float* s = scr + (8 * i + (lane >> 3)) * 33 + (lane & 7) * 4; s[0] = v[i][0]; s[1] = v[i][1]; s[2] = v[i][2]; s[3] = v[i][3]; }
    LDS_WAIT();
    const int c = lane & 7;
#pragma unroll
    for (int j = 0; j < 4; ++j) { const int n = (lane >> 3) + 8 * j; const LAS float* s = scr + (8 * c) * 33 + n;
        u32x4 o; o.x = cvtpk(s[0 * 33], s[1 * 33]); o.y = cvtpk(s[2 * 33], s[3 * 33]); o.z = cvtpk(s[4 * 33], s[5 * 33]); o.w = cvtpk(s[6 * 33], s[7 * 33]);
        *(u32x4*)(WT + (size_t)(dst_row0 + n) * ldt + k0 + 8 * c) = o; }
    LDS_WAIT();
}

DI void sincos2pi(double frac, float& cs, float& sn) {
    const double rr = frac - __builtin_rint(frac);
    const double x = rr * 6.283185307179586476925286766559, x2 = x * x;
    double c = 1.0, s = x, tc = 1.0, ts = x;
#pragma unroll 1
    for (int k = 1; k <= 14; ++k) { tc = -tc * x2 / (double)((2 * k - 1) * (2 * k)); ts = -ts * x2 / (double)((2 * k) * (2 * k + 1)); c += tc; s += ts; }
    cs = (float)c; sn = (float)s;
}

DI void first_norm(const float* xlo, const float* xhi, const float* g, const float* mod, bf16_t* H, float* SS, int gw, int ngw, int lane_) {
    const int lane = opq(lane_);
    for (int rb = gw; rb < NTOK / 8; rb += ngw) {
        const int row0 = rb * 8; const bool hi = row0 >= NCTX; const int cond = hi ? 1 + ((row0 - NCTX) >> 12) : 0;
        const float* mc = mod + cond * NMODC;
        f32x4 gs[4];
#pragma unroll
        for (int j = 0; j < 4; ++j) { const int col = 4 * lane + 256 * j; gs[j] = *(const f32x4*)(g + col) * (*(const f32x4*)(mc + 1024 + col) + 1.0f); }
#pragma unroll 2
        for (int i = 0; i < 8; ++i) {
            const int row = row0 + i;
            const float* xr = hi ? xhi + (size_t)(row - NCTX) * 1024 : xlo + (size_t)row * 1024;
            f32x4 v[4]; float ss = 0.f;
#pragma unroll
            for (int j = 0; j < 4; ++j) { v[j] = *(const f32x4*)(xr + 4 * lane + 256 * j); ss += (v[j].x * v[j].x + v[j].y * v[j].y) + (v[j].z * v[j].z + v[j].w * v[j].w); }
            ss = wave_sum(ss, lane);
            if (lane == 0) *(f32x4*)(SS + (size_t)row * 4) = (f32x4){ss, 0.f, 0.f, 0.f};
            bf16_t* hr = H + (size_t)row * 1024 + 4 * lane;
#pragma unroll
            for (int j = 0; j < 4; ++j) { const f32x4 y = v[j] * gs[j]; u32x2 w; w.x = cvtpk(y.x, y.y); w.y = cvtpk(y.z, y.w); *(u32x2*)(hr + 256 * j) = w; }
        }
    }
}
DI void shw_rows(const bf16_t* W, int nrows, const float* sh, float* out, int ostride, int gw, int ngw, int lane_) {
    const int lane = opq(lane_);
    f32x4 s[3][4];
#pragma unroll
    for (int c = 0; c < 3; ++c)
#pragma unroll
        for (int j = 0; j < 2; ++j) { s[c][2 * j] = *(const f32x4*)(sh + c * NMODC + 8 * lane + 512 * j); s[c][2 * j + 1] = *(const f32x4*)(sh + c * NMODC + 8 * lane + 512 * j + 4); }
    for (int n = gw; n < nrows; n += ngw) {
        const bf16_t* wr = W + (size_t)n * 1024 + 8 * lane;
        float a0 = 0.f, a1 = 0.f, a2 = 0.f;
#pragma unroll
        for (int j = 0; j < 2; ++j) { const bf16x8 w = *(const bf16x8*)(wr + 512 * j);
#pragma unroll
            for (int e = 0; e < 8; ++e) { const float wf = bf2f(w[e]); a0 += wf * s[0][2 * j + (e >> 2)][e & 3]; a1 += wf * s[1][2 * j + (e >> 2)][e & 3]; a2 += wf * s[2][2 * j + (e >> 2)][e & 3]; } }
        a0 = wave_sum(a0, lane); a1 = wave_sum(a1, lane); a2 = wave_sum(a2, lane);
        if (lane == 0) { out[n] = a0; out[ostride + n] = a1; out[2 * ostride + n] = a2; }
    }
}

#define XB_TMO      128
#define XB_XCNT(j)  (256  + 64 * (j))
#define XB_XSUB(j)  (1280 + 64 * (j))
#define XB_XGEN(j)  (2304 + 64 * (j))
#define XB_TOP      3328
#define XB_TOPGEN   3392
#define XCD_BAR_WORDS 3456
#define XB_SPIN_CAP (1u << 18)
static_assert(XCD_BAR_WORDS * 4 <= (int)BAR_BYTES, "barrier words inside the memset region");
DI unsigned xb_ld(unsigned* p)              { return __hip_atomic_load(p, __ATOMIC_RELAXED, __HIP_MEMORY_SCOPE_AGENT); }
DI unsigned xb_add(unsigned* p, unsigned v) { return __hip_atomic_fetch_add(p, v, __ATOMIC_RELAXED, __HIP_MEMORY_SCOPE_AGENT); }
DI unsigned xb_xcc_id() { return (unsigned)__builtin_amdgcn_s_getreg((3 << 11) | 20) & 0xFu; }
#define XB_SPIN(cond, bar) do { unsigned _sp = 0; while (cond) { __builtin_amdgcn_s_sleep(1); \
    if ((++_sp & 255u) == 0u) { if (xb_ld(&(bar)[XB_TMO])) break; if (_sp > XB_SPIN_CAP) { atomicAdd(&(bar)[XB_TMO], 1u); break; } } } } while (0)
struct XcdBarrier { unsigned* bar; unsigned x; volatile LAS unsigned* st; };
DI void xcd_barrier_complete(unsigned* bar, unsigned x, unsigned& nloc, unsigned& nx) {
    const unsigned G = gridDim.x * gridDim.y * gridDim.z;
    unsigned sum, cnt, mine, sp = 0u;
    for (;;) {
        sum = 0u; cnt = 0u; mine = 0u;
#pragma unroll
        for (unsigned j = 0; j < 16; ++j) { const unsigned c = xb_ld(&bar[XB_XCNT(j)]); sum += c; cnt += (c > 0u) ? 1u : 0u; mine = (j == x) ? c : mine; }
        if (sum == G) break;
        __builtin_amdgcn_s_sleep(1);
        if ((++sp & 255u) == 0u) { if (xb_ld(&bar[XB_TMO])) break; if (sp > XB_SPIN_CAP) { atomicAdd(&bar[XB_TMO], 1u); break; } }
    }
    nloc = mine > 0u ? mine : 1u; nx = cnt > 0u ? cnt : 1u;
}
DI void xcd_barrier(const XcdBarrier& b) {
    asm volatile("s_waitcnt vmcnt(0)" ::: "memory");
    __syncthreads();
    if (threadIdx.x == 0) {
        unsigned* bar = b.bar;
        __builtin_amdgcn_s_waitcnt(0);
        unsigned nloc = b.st[0], nx = b.st[1];
        if (nloc == 0u) { xcd_barrier_complete(bar, b.x, nloc, nx); b.st[0] = nloc; b.st[1] = nx; }
        const unsigned old = xb_add(&bar[XB_XSUB(b.x)], 1u);
        const unsigned gen = old / nloc;
        if (old + 1u == (gen + 1u) * nloc) {
            __builtin_amdgcn_fence(__ATOMIC_RELEASE, "agent");
            asm volatile("s_waitcnt vmcnt(0)" ::: "memory");
            const unsigned og = xb_add(&bar[XB_TOP], 1u);
            const unsigned tg = og / nx;
            if (og + 1u == (tg + 1u) * nx) xb_add(&bar[XB_TOPGEN], 1u);
            else XB_SPIN(xb_ld(&bar[XB_TOPGEN]) == tg, bar);
            __builtin_amdgcn_fence(__ATOMIC_ACQUIRE, "agent");
            xb_add(&bar[XB_XGEN(b.x)], 1u);
            asm volatile("s_waitcnt vmcnt(0)" ::: "memory");
        } else {
            XB_SPIN(xb_ld(&bar[XB_XGEN(b.x)]) == gen, bar);
            __builtin_amdgcn_fence(__ATOMIC_ACQUIRE, "agent");
            asm volatile("s_waitcnt vmcnt(0)" ::: "memory");
        }
    }
    __syncthreads();
}
#define GRID_BAR() do { XcdBarrier _b; _b.bar = (unsigned*)(kparams()->ws + WS_BAR); _b.x = xb_xcc_id(); _b.st = (volatile LAS unsigned*)(lds + LDS_MISC); xcd_barrier(_b); } while (0)

typedef const __attribute__((address_space(4))) Params* KP;
DI KP kparams() { KP p = (KP)__builtin_amdgcn_kernarg_segment_ptr(); asm volatile("" : "+s"(p)); return p; }
#define PH_ENTER const int tid = opq(threadIdx.x), lane = tid & 63, wave = __builtin_amdgcn_readfirstlane(tid >> 6); const int gw = vcu * 8 + wave; const int G = sopq(G0), ngw = G * 8; (void)ngw; \
    KP PP = kparams(); unsigned char* ws = PP->ws; unsigned char* mix = ws + WS_MIX; float* X = PP->out; (void)lane; (void)gw; (void)mix; (void)X; (void)tid;

__global__ void __launch_bounds__(512) mega_fwd(Params P_unused) {
    extern __shared__ __attribute__((aligned(16))) unsigned char lds_raw[];
    LAS unsigned char* lds = (LAS unsigned char*)lds_raw;
    cg::grid_group grid = cg::this_grid();
    const int G0 = gridDim.x, bx = blockIdx.x;
    const int vcu = (G0 % 8 == 0) ? (bx % 8) * (G0 / 8) + bx / 8 : bx;
    if (threadIdx.x < 2) ((volatile LAS unsigned*)(lds + LDS_MISC))[threadIdx.x] = 0u;
    __syncthreads();
    if (threadIdx.x == 0) (void)xb_add(&((unsigned*)(kparams()->ws + WS_BAR))[XB_XCNT(xb_xcc_id())], 1u);

    {
        PH_ENTER
        bf16_t* GU_T = (bf16_t*)(ws + WS_GU_T); bf16_t* D_T = (bf16_t*)(ws + WS_D_T); bf16_t* DQKV_T = (bf16_t*)(ws + WS_DQKV_T);
        bf16_t* UQ_T = (bf16_t*)(ws + WS_UQ_T); bf16_t* UK_T = (bf16_t*)(ws + WS_UK_T); bf16_t* UV_T = (bf16_t*)(ws + WS_UV_T);
        bf16_t* WO_T = (bf16_t*)(ws + WS_WO_T); bf16_t* FW_T = (bf16_t*)(ws + WS_FW_T);
        LAS float* scr = (LAS float*)(lds + wave * 8704);
        constexpr int NITEMS = 22528 + 11264 + 512 + 320 + 768 + 512 + 1024 + 1024;
        for (int rp = 0; rp < REP_PRO; ++rp) {
        for (int it = gw; it < NITEMS; it += ngw) {
            int r = it;
            if (r < 22528) { const int mtx = r / 1408, it2 = r % 1408, lf = mtx >> 1, gu = mtx & 1, kb = it2 / 88, n0 = (it2 % 88) * 32;
                transpose_item((gu ? PP->wu : PP->wg) + (size_t)lf * 1024 * DFF, DFF, GU_T + (size_t)lf * 5632 * 1024, 1024, (n0 >> 7) * 256 + gu * 128 + (n0 & 127), scr, kb * 64, n0, lane); continue; }
            r -= 22528;
            if (r < 11264) { const int mtx = r / 1408, it2 = r % 1408, kb = it2 / 32, n0 = (it2 % 32) * 32;
                transpose_item(PP->wd + (size_t)mtx * DFF * 1024, 1024, D_T + (size_t)mtx * 1024 * DFF, DFF, n0, scr, kb * 64, n0, lane); continue; }
            r -= 11264;
            if (r < 512) { const int j = r / 256, it2 = r % 256, kb = it2 / 16, n0 = (it2 % 16) * 32;
                transpose_item(PP->w_dq + (size_t)j * 1024 * 512, 512, DQKV_T + (size_t)j * 1024 * 1024, 1024, n0, scr, kb * 64, n0, lane); continue; }
            r -= 512;
            if (r < 320) { const int j = r / 160, it2 = r % 160, kb = it2 / 10, n0 = (it2 % 10) * 32;
                transpose_item(PP->w_dkv + (size_t)j * 1024 * 320, 320, DQKV_T + (size_t)j * 1024 * 1024, 1024, 512 + n0, scr, kb * 64, n0, lane); continue; }
            r -= 320;
            if (r < 768) { const int j = r / 384, it2 = r % 384, kb = it2 / 48, n0 = (it2 % 48) * 32;
                transpose_item(PP->w_uq + (size_t)j * 512 * 1536, 1536, UQ_T + (size_t)j * 1536 * 512, 512, n0, scr, kb * 64, n0, lane); continue; }
            r -= 768;
            if (r < 512) { const int j = r / 256, it2 = r % 256, kb = it2 / 64, n0 = (it2 % 64) * 32, hh = n0 >> 8, cc = n0 & 255;
                bf16_t* dst = (cc < 128 ? UK_T : UV_T) + (size_t)j * 1024 * 256;
                transpose_item(PP->w_ukv + (size_t)j * 256 * 2048, 2048, dst, 256, hh * 128 + (cc & 127), scr, kb * 64, n0, lane); continue; }
            r -= 512;
            if (r < 1024) { const int j = r / 512, it2 = r % 512, kb = it2 / 32, n0 = (it2 % 32) * 32;
                transpose_item(PP->w_o + (size_t)j * 1024 * 1024, 1024, WO_T + (size_t)j * 1024 * 1024, 1024, n0, scr, kb * 64, n0, lane); continue; }
            r -= 1024;
            { const int j = r / 512, it2 = r % 512, kb = it2 / 32, n0 = (it2 % 32) * 32;
                transpose_item(PP->fw + (size_t)j * 1024 * 1024, 1024, FW_T + (size_t)j * 1024 * 2048, 2048, n0, scr, kb * 64, n0, lane);
                transpose_item(PP->fw + (size_t)j * 1024 * 1024, 1024, FW_T + (size_t)j * 1024 * 2048 + 1024, 2048, n0, scr, kb * 64, n0, lane); }
        }
        float* PART = (float*)(mix + MX_MODPART);
        const float* c_ctx = PP->c_ctx; const float* cc = PP->c; const float* w_mod = PP->w_mod;
        for (int item = bx; item < 256; item += G) {
            const int l = item >> 6, kc = item & 63;
            f32x4 acc[3][5];
#pragma unroll
            for (int cnd = 0; cnd < 3; ++cnd)
#pragma unroll
                for (int jj = 0; jj < 5; ++jj) acc[cnd][jj] = (f32x4){0.f, 0.f, 0.f, 0.f};
            const bool has5 = tid < 256;
#pragma unroll 2
            for (int kk = 0; kk < 16; ++kk) {
                const int k = kc * 16 + kk;
                const float s0 = silu_f(c_ctx[k]), s1 = silu_f(cc[k]), s2 = silu_f(cc[1024 + k]);
                const float* wrow = w_mod + ((size_t)l * 1024 + k) * NMODC + 4 * tid;
#pragma unroll
                for (int jj = 0; jj < 5; ++jj) { if (jj < 4 || has5) { const f32x4 w = *(const f32x4*)(wrow + 2048 * jj); acc[0][jj] += w * s0; acc[1][jj] += w * s1; acc[2][jj] += w * s2; } }
            }
#pragma unroll
            for (int cnd = 0; cnd < 3; ++cnd)
#pragma unroll
                for (int jj = 0; jj < 5; ++jj) if (jj < 4 || has5) *(f32x4*)(PART + ((size_t)item * 3 + cnd) * NMODC + 4 * tid + 2048 * jj) = acc[cnd][jj];
        }
        }
        if (bx == G - 1) {
            float* ROPE = (float*)(ws + WS_ROPE); float* TAB = (float*)(ws + WS_TAB);
            for (int e = tid; e < 1024; e += 512) { const int idx = e >> 4, f = e & 15; double inv = 1.0; for (int q = 0; q < f; ++q) inv *= 0.56234132519034908;
                float cs, sn; sincos2pi((double)idx * inv * 0.15915494309189533577, cs, sn); ROPE[e] = cs; ROPE[1024 + e] = sn; }
            for (int e = tid; e < 4096; e += 512) { float cs, sn; sincos2pi((double)e * (1.0 / 4096.0), cs, sn); TAB[e] = cs; TAB[4096 + e] = sn; }
        }
    }
    grid.sync();
    {
        PH_ENTER
        const float* PART = (const float*)(mix + MX_MODPART); float* MOD = (float*)(ws + WS_MOD); const float* b_mod = PP->b_mod;
        for (int e = bx * 512 + tid; e < 4 * MODL; e += G * 512) {
            const int l = e / MODL, rem = e % MODL, n = rem % NMODC;
            float s = b_mod[l * NMODC + n];
#pragma unroll 8
            for (int kc = 0; kc < 64; ++kc) s += PART[(size_t)(l * 64 + kc) * MODL + rem];
            MOD[e] = s;
        }
        bf16_t* DS = (bf16_t*)(ws + WS_DS); bf16_t* DC = (bf16_t*)(ws + WS_DC); bf16_t* CS = (bf16_t*)(ws + WS_CS); const float* TAB = (const float*)(ws + WS_TAB);
        for (int ch = bx * 512 + tid; ch < 4096 * 1024; ch += G * 512) {
            const int s = ch >> 10, k0 = (ch & 1023) * 8; const bool sn = k0 >= 4096; const int kk = sn ? k0 - 4096 : k0;
            float v[8];
#pragma unroll
            for (int j = 0; j < 8; ++j) { const int ix = (s * (kk + j)) & 4095; v[j] = sn ? -TAB[4096 + ix] * 0.015625f : TAB[ix] * 0.015625f; }
            u32x4 w; w.x = cvtpk(v[0], v[1]); w.y = cvtpk(v[2], v[3]); w.z = cvtpk(v[4], v[5]); w.w = cvtpk(v[6], v[7]);
            *(u32x4*)(DS + (size_t)s * 8192 + k0) = w;
        }
        for (int e = bx * 512 + tid; e < 256 * 512; e += G * 512) {
            const int s = e >> 9, k = e & 511; const bool sn = k >= 256; const int ix = ((s * (sn ? k - 256 : k)) & 255) * 16;
            DC[e] = f2bf(sn ? -TAB[4096 + ix] * 0.0625f : TAB[ix] * 0.0625f);
        }
        for (int e = bx * 512 + tid; e < 512 * 256; e += G * 512) {
            const int m = e >> 8, k = e & 255; const bool sn = m >= 256; const int ix = (((sn ? m - 256 : m) * k) & 255) * 16;
            CS[e] = f2bf(sn ? TAB[4096 + ix] * 0.0625f : TAB[ix] * 0.0625f);
        }
    }
    GRID_BAR();
    {
        PH_ENTER
        const float* MOD = (const float*)(ws + WS_MOD); const float* norm_g = PP->norm_g;
        float* GS = (float*)(ws + WS_GS);
        for (int e = bx * 512 + tid; e < 12 * 3 * 1024; e += G * 512) {
            const int p = e / 3072, rem = e % 3072, cnd = rem >> 10, col = rem & 1023, l = p / 3, sub = p % 3;
            GS[e] = norm_g[p * 1024 + col] * (1.0f + MOD[l * MODL + cnd * NMODC + (3 * sub + 1) * 1024 + col]);
        }
        for (int lf = 0; lf < 8; ++lf)
            shw_rows((const bf16_t*)(ws + WS_GU_T) + (size_t)lf * 5632 * 1024, 5632, MOD + (lf >> 1) * MODL + ((lf & 1) * 6) * 1024, (float*)(ws + WS_SHWGU) + (size_t)lf * 3 * 5632, 5632, gw, ngw, lane);
        for (int j = 0; j < 2; ++j)
            shw_rows((const bf16_t*)(ws + WS_DQKV_T) + (size_t)j * 1024 * 1024, 832, MOD + (2 * j) * MODL + 3 * 1024, (float*)(ws + WS_SHWDQ) + (size_t)j * 3 * 1024, 1024, gw, ngw, lane);
        { const bf16_t* CS = (const bf16_t*)(ws + WS_CS); float* SHC = (float*)(ws + WS_SHC);
          for (int e = bx * 512 + tid; e < 2 * 3 * 4 * 512; e += G * 512) {
              const int j = e / 6144, rem = e % 6144, cnd = rem / 2048, gq = (rem >> 9) & 3, m = rem & 511;
              const float* sh = MOD + (2 * j + 1) * MODL + cnd * NMODC + 3 * 1024 + gq * 256; const bf16_t* cr = CS + m * 256;
              float a = 0.f;
              for (int k = 0; k < 256; ++k) a += bf2f((short)cr[k]) * sh[k];
              SHC[e] = a;
          } }
        first_norm(PP->x_prompt, PP->x_sample, norm_g, MOD, (bf16_t*)(ws + WS_H), (float*)(ws + WS_SS), gw, ngw, lane);
    }
    GRID_BAR();

    for (int l = 0; l < 4; ++l) {
        for (int sub = 0; sub < 3; ++sub) {
#define XSRC const bool first = (l == 0 && sub == 0); const float* xlo = first ? PP->x_prompt : X; const float* xhi = first ? PP->x_sample : X + (size_t)NCTX * DM; \
             const float* modl = (const float*)(ws + WS_MOD) + l * MODL; const int jm = l >> 1; const int np = l * 3 + sub; const bool hn = np < 11; \
             const float* SSp = (const float*)(ws + WS_SS) + (size_t)np * NTOK * 4; float* SSn = (float*)(ws + WS_SS) + (size_t)(hn ? np + 1 : np) * NTOK * 4; const float* GSn = (const float*)(ws + WS_GS) + (size_t)(np + 1) * 3072; \
             bf16_t* Hn = (bf16_t*)(ws + WS_H); (void)jm; (void)modl; (void)xlo; (void)xhi; (void)SSp; (void)SSn; (void)GSn; (void)Hn;
            if (sub != 1) {
                {
                    PH_ENTER XSRC
                    const int lf = l * 2 + (sub >> 1);
                    pg8::Gemm g{(const bf16_t*)(ws + WS_H), (const bf16_t*)(ws + WS_GU_T) + (size_t)lf * 5632 * 1024, 1024, 1024, 1024, 64, 22, 1, 0, 0}; pg8::Order S; S.init(g, G, bx);
                    pg8::EpiSwiglu E{(bf16_t*)(mix + MX_ACT), SSp, (const float*)(ws + WS_SHWGU) + (size_t)lf * 3 * 5632}; for (int rp = 0; rp < REP_GU; ++rp) pg8::gemm_phase(lds, g, S, E);
                }
                GRID_BAR();
                {
                    PH_ENTER XSRC
                    const int lf = l * 2 + (sub >> 1);
                    pg8::Gemm g{(const bf16_t*)(mix + MX_ACT), (const bf16_t*)(ws + WS_D_T) + (size_t)lf * 1024 * DFF, DFF, DFF, DFF, 64, 4, 1, 0, 0}; pg8::Order S; S.init(g, G, bx);
                    pg8::EpiResid E{xlo, xhi, X, modl + (3 * sub + 2) * 1024, nullptr, Hn, GSn, SSn, lds, 0.5f, hn ? 1 : 0}; pg8::gemm_phase(lds, g, S, E);
                }
                GRID_BAR();
            } else {
                if ((l & 1) == 0) {
                    {
                        PH_ENTER XSRC
                        pg8::Gemm g{(const bf16_t*)(ws + WS_H), (const bf16_t*)(ws + WS_DQKV_T) + (size_t)jm * 1024 * 1024, 1024, 1024, 1024, 64, 4, 1, 0, 0}; pg8::Order S; S.init(g, G, bx);
                        pg8::EpiF32 E{(float*)(mix + MX_CQRAW), SSp, (const float*)(ws + WS_SHWDQ) + (size_t)jm * 3 * 1024}; pg8::gemm_phase(lds, g, S, E);
                    }
                    GRID_BAR();
                    {
                        PH_ENTER XSRC
                        const float* CQRAW = (const float*)(mix + MX_CQRAW); bf16_t* CQ = (bf16_t*)(mix + MX_CQ); bf16_t* CKV = (bf16_t*)(mix + MX_CKV); bf16_t* KPE = (bf16_t*)(mix + MX_KPE);
                        const float* ROPE = (const float*)(ws + WS_ROPE);
                        float* NEW_CKV = X + (size_t)NTOK * DM; float* NEW_KPE = NEW_CKV + (size_t)32 * 2 * 256 * 256;
                        const float* qn = PP->q_norm + jm * 512; const float* kn = PP->kv_norm + jm * 256;
                        const float* cache_ckv = PP->cache_ckv; const float* cache_kpe = PP->cache_kpe;
                        for (int kvrow = gw; kvrow < KVROWS; kvrow += ngw) {
                            int tok = -1, bb = 0, tt = 0, spos = 0; bool lat = false;
                            if (kvrow < NCTX) tok = kvrow;
                            else { const int rel = kvrow - NCTX; bb = rel / KVB; tt = rel % KVB; if (tt >= 512) { lat = true; spos = tt - 512; tok = NCTX + bb * 4096 + spos; } }
                            if (tok >= 0) {
                                const float* raw = CQRAW + (size_t)tok * 1024;
                                const f32x4 q0 = *(const f32x4*)(raw + 4 * lane), q1 = *(const f32x4*)(raw + 256 + 4 * lane), kv = *(const f32x4*)(raw + 512 + 4 * lane);
                                const float ssq = wave_sum((q0.x * q0.x + q0.y * q0.y) + (q0.z * q0.z + q0.w * q0.w) + (q1.x * q1.x + q1.y * q1.y) + (q1.z * q1.z + q1.w * q1.w), lane);
                                const float ssk = wave_sum((kv.x * kv.x + kv.y * kv.y) + (kv.z * kv.z + kv.w * kv.w), lane);
                                const float rq = 1.0f / sqrtf(ssq * (1.0f / 512.0f) + EPS), rk = 1.0f / sqrtf(ssk * (1.0f / 256.0f) + EPS);
                                const f32x4 y0 = q0 * rq * *(const f32x4*)(qn + 4 * lane), y1 = q1 * rq * *(const f32x4*)(qn + 256 + 4 * lane), yk = kv * rk * *(const f32x4*)(kn + 4 * lane);
                                u32x2 w; w.x = cvtpk(y0.x, y0.y); w.y = cvtpk(y0.z, y0.w); *(u32x2*)(CQ + (size_t)tok * 512 + 4 * lane) = w;
                                w.x = cvtpk(y1.x, y1.y); w.y = cvtpk(y1.z, y1.w); *(u32x2*)(CQ + (size_t)tok * 512 + 256 + 4 * lane) = w;
                                w.x = cvtpk(yk.x, yk.y); w.y = cvtpk(yk.z, yk.w); *(u32x2*)(CKV + (size_t)kvrow * 256 + 4 * lane) = w;
                                const size_t orow = (size_t)((tok >> 8) * 2 + jm) * 256 + (tok & 255);
                                if (!lat) *(f32x4*)(NEW_CKV + orow * 256 + 4 * lane) = yk;
                                if (lane < 32) {
                                    const int a = lane >> 4, f = lane & 15; const float x1 = raw[768 + a * 32 + f], x2 = raw[768 + a * 32 + 16 + f];
                                    float o1 = x1, o2 = x2;
                                    if (lat) { const int idx = a ? (spos & 63) : (spos >> 6); const float cr = ROPE[idx * 16 + f], sn = ROPE[1024 + idx * 16 + f]; o1 = x1 * cr - x2 * sn; o2 = x2 * cr + x1 * sn; }
                                    else { NEW_KPE[orow * 64 + a * 32 + f] = o1; NEW_KPE[orow * 64 + a * 32 + 16 + f] = o2; }
                                    KPE[(size_t)kvrow * 64 + a * 32 + f] = f2bf(o1); KPE[(size_t)kvrow * 64 + a * 32 + 16 + f] = f2bf(o2);
                                }
                            } else {
                                const size_t crow = (size_t)((bb * 2 + jm) * 512 + tt);
                                const f32x4 cv = *(const f32x4*)(cache_ckv + crow * 256 + 4 * lane);
                                u32x2 w; w.x = cvtpk(cv.x, cv.y); w.y = cvtpk(cv.z, cv.w); *(u32x2*)(CKV + (size_t)kvrow * 256 + 4 * lane) = w;
                                if (lane < 16) { const f32x4 pv = *(const f32x4*)(cache_kpe + crow * 64 + 4 * lane); w.x = cvtpk(pv.x, pv.y); w.y = cvtpk(pv.z, pv.w); *(u32x2*)(KPE + (size_t)kvrow * 64 + 4 * lane) = w; }
                            }
                        }
                    }
                    GRID_BAR();
                    for (int which = 0; which < 3; ++which) {
                        PH_ENTER
                        const int jm = l >> 1;
                        bf16_t* CQ = (bf16_t*)(mix + MX_CQ); bf16_t* CKV = (bf16_t*)(mix + MX_CKV);
                        pg8::Gemm g; pg8::EpiBf16 E; int rot;
                        if (which == 0) { g = pg8::Gemm{CQ, (const bf16_t*)(ws + WS_UQ_T) + (size_t)jm * 1536 * 512, 512, 512, 512, 64, 6, 1, 0, 0}; E = pg8::EpiBf16{(bf16_t*)(mix + MX_Q), 1536, 0, QSCALE}; rot = 0; }
                        else if (which == 1) { g = pg8::Gemm{CKV, (const bf16_t*)(ws + WS_UK_T) + (size_t)jm * 1024 * 256, 256, 256, 256, 68, 4, 1, 0, 0}; E = pg8::EpiBf16{(bf16_t*)(mix + MX_KN), 1024, 0, 1.0f}; rot = 384; }
                        else { g = pg8::Gemm{(const bf16_t*)(ws + WS_UV_T) + (size_t)jm * 1024 * 256, CKV, 256, 256, 256, 4, 68, 1, 0, 0}; E = pg8::EpiBf16{(bf16_t*)(mix + MX_VT), KVROWS, 0, 1.0f}; rot = 384 + 272; }
                        pg8::Order S; S.init(g, G, (bx + G - rot % G) % G);
                        pg8::gemm_phase(lds, g, S, E);
                    }
                    GRID_BAR();
                    {
                        PH_ENTER
                        AttnT T{(const bf16_t*)(mix + MX_Q), (const bf16_t*)(mix + MX_KN), (const bf16_t*)(mix + MX_KPE), (const bf16_t*)(mix + MX_VT), (bf16_t*)(mix + MX_O), (const float*)(ws + WS_ROPE)};
                        for (int rp = 0; rp < REP_ATTN; ++rp) {
                        for (int u = vcu; u < 256; u += G) { const int bh = u >> 4, qb = u & 15, b = bh >> 3, hh = bh & 7;
                            attn_unit(lds, T, NCTX + b * 4096 + qb * 256, hh, NCTX + b * KVB, KVB, qb * 256, true); }
                        for (int u = vcu; u < 256; u += G) { const int b = u >> 3, hh = u & 7;
                            attn_unit(lds, T, b * 256, hh, b * 256, 256, 0, false); }
                        }
                    }
                    GRID_BAR();
                } else {
                    {
                        PH_ENTER XSRC
                        pg8::Gemm g{(const bf16_t*)(ws + WS_CS), (const bf16_t*)(ws + WS_H), 256, 1024, 256, 2, 64, 4, 0, 256}; pg8::Order S; S.init(g, G, bx);
                        pg8::EpiYt E{(bf16_t*)(mix + MX_YTC), (bf16_t*)(mix + MX_YTL), SSp, (const float*)(ws + WS_SHC) + (size_t)jm * 3 * 4 * 512}; pg8::gemm_phase(lds, g, S, E);
                    }
                    GRID_BAR();
                    for (int which = 0; which < 2; ++which) {
                        PH_ENTER
                        bf16_t* F = (bf16_t*)(mix + MX_F);
                        pg8::Gemm g; pg8::EpiBf16 E; int rot;
                        if (which == 0) { g = pg8::Gemm{(const bf16_t*)(ws + WS_DS), (const bf16_t*)(mix + MX_YTL), 8192, 8192, 4096, 16, 4, 4, 0, (long)1024 * 8192, 1, 4096, 4096};
                            E = pg8::EpiBf16{F + (size_t)NCTX * 2048, 2048, (long)4096 * 2048, 1.0f, 1, 1024}; rot = 0; }
                        else { g = pg8::Gemm{(const bf16_t*)(ws + WS_DC), (const bf16_t*)(mix + MX_YTC), 512, 512, 256, 1, 4, 64, 0, (long)1024 * 512, 1, 256, 256};
                            E = pg8::EpiBf16{F, 2048, (long)256 * 2048, 1.0f, 1, 1024}; rot = 0; }
                        pg8::Order S; S.init(g, G, (bx + G - rot % G) % G);
                        pg8::gemm_phase(lds, g, S, E);
                    }
                    GRID_BAR();
                }
                {
                    PH_ENTER XSRC
                    const bool mla = (l & 1) == 0;
                    const bf16_t* mixA = (const bf16_t*)(mix + (mla ? MX_O : MX_F));
                    const bf16_t* mixW = (const bf16_t*)(ws + (mla ? WS_WO_T : WS_FW_T)) + (size_t)jm * 1024 * (mla ? 1024 : 2048); const int mixK = mla ? 1024 : 2048;
                    const float* mixBias = mla ? nullptr : PP->fb + jm * 1024;
                    pg8::Gemm g{mixA, mixW, mixK, mixK, mixK, 64, 4, 1, 0, 0}; pg8::Order S; S.init(g, G, bx);
                    pg8::EpiResid E{xlo, xhi, X, modl + 5 * 1024, mixBias, Hn, GSn, SSn, lds, 1.0f, hn ? 1 : 0}; pg8::gemm_phase(lds, g, S, E);
                }
                GRID_BAR();
            }
        }
    }
    {
        PH_ENTER
        const float* fn = PP->final_norm;
        for (int row = gw; row < NTOK; row += ngw) {
            float* xr = X + (size_t)row * 1024 + 4 * lane;
            f32x4 v[4]; float ss = 0.f;
#pragma unroll
            for (int j = 0; j < 4; ++j) { v[j] = *(const f32x4*)(xr + 256 * j); ss += (v[j].x * v[j].x + v[j].y * v[j].y) + (v[j].z * v[j].z + v[j].w * v[j].w); }
            const float rs = 1.0f / sqrtf(wave_sum(ss, lane) * (1.0f / 1024.0f) + EPS);
#pragma unroll
            for (int j = 0; j < 4; ++j) *(f32x4*)(xr + 256 * j) = v[j] * rs * *(const f32x4*)(fn + 4 * lane + 256 * j);
        }
    }
}

extern "C" void kernel_launch(void* const* d_in, const int* in_sizes, int n_in, void* d_out, int out_size, void* d_ws, size_t ws_size, hipStream_t stream) {
    static int grid_blocks = 0;
    if (grid_blocks == 0) {
        if (n_in != 22 || ws_size < WS_END) { fprintf(stderr, "kernel_launch: need 22 inputs and >= %zu bytes of workspace (got %d, %zu)\n", (size_t)WS_END, n_in, ws_size); grid_blocks = -1; return; }
        int dev = 0, cus = 0, per_cu = 0;
        hipGetDevice(&dev);
        hipDeviceGetAttribute(&cus, hipDeviceAttributeMultiprocessorCount, dev);
        hipFuncSetAttribute((const void*)mega_fwd, hipFuncAttributeMaxDynamicSharedMemorySize, LDS_BYTES);
        hipOccupancyMaxActiveBlocksPerMultiprocessor(&per_cu, (const void*)mega_fwd, 512, LDS_BYTES);
        if (per_cu < 1) { fprintf(stderr, "kernel_launch: occupancy query says %d blocks per CU\n", per_cu); per_cu = 1; }
        (void)hipGetLastError();
        grid_blocks = cus;
    }
    if (grid_blocks < 0) return;
    (void)hipMemsetAsync((char*)d_ws + WS_BAR, 0, BAR_BYTES, stream);
    Params p{};
    const float** pp = (const float**)&p;
    for (int i = 0; i < 22; ++i) pp[i] = (const float*)d_in[i];
    p.out = (float*)d_out; p.ws = (unsigned char*)d_ws;
    void* args[] = {&p};
    hipError_t e = hipLaunchCooperativeKernel((const void*)mega_fwd, dim3(grid_blocks), dim3(512), args, LDS_BYTES, stream);
    if (e != hipSuccess) fprintf(stderr, "cooperative launch failed: %s (grid %d)\n", hipGetErrorString(e), grid_blocks);
}
```

```cpp
#include <hip/hip_runtime.h>
#include <hip/hip_cooperative_groups.h>
#include <cstdio>
#include <cstdint>
namespace cg = cooperative_groups;

#define LAS __attribute__((address_space(3)))
typedef unsigned short bf16_t;
typedef short bf16x8 __attribute__((ext_vector_type(8)));
typedef float f32x4 __attribute__((ext_vector_type(4)));
typedef float f32x2 __attribute__((ext_vector_type(2)));
typedef float f32x16 __attribute__((ext_vector_type(16)));
typedef unsigned u32x4 __attribute__((ext_vector_type(4)));
typedef unsigned u32x2 __attribute__((ext_vector_type(2)));
typedef __bf16 bf16x2_t __attribute__((ext_vector_type(2)));
#define DI __device__ __forceinline__

constexpr int DM = 1024, NTOK = 16384, NCTX = 8192, DFF = 2816, NMODC = 9216, MODL = 3 * NMODC;
constexpr int KVROWS = 17408;
constexpr int KVB = 4608;
constexpr float EPS = 1e-6f;
constexpr float QSCALE = 0.07216878364870323f * 1.4426950408889634f;

constexpr size_t al256(size_t x) { return (x + 255) & ~(size_t)255; }
constexpr size_t WS_BAR = 0, BAR_BYTES = 16384;
constexpr size_t WS_MOD = BAR_BYTES;
constexpr size_t WS_ROPE = al256(WS_MOD + (size_t)4 * MODL * 4);
constexpr size_t WS_TAB = al256(WS_ROPE + 2048 * 4);
constexpr size_t WS_GU_T = al256(WS_TAB + 8192 * 4);
constexpr size_t WS_D_T = al256(WS_GU_T + (size_t)8 * 5632 * 1024 * 2);
constexpr size_t WS_DQKV_T = al256(WS_D_T + (size_t)8 * 1024 * 2816 * 2);
constexpr size_t WS_UQ_T = al256(WS_DQKV_T + (size_t)2 * 1024 * 1024 * 2);
constexpr size_t WS_UK_T = al256(WS_UQ_T + (size_t)2 * 1536 * 512 * 2);
constexpr size_t WS_UV_T = al256(WS_UK_T + (size_t)2 * 1024 * 256 * 2);
constexpr size_t WS_WO_T = al256(WS_UV_T + (size_t)2 * 1024 * 256 * 2);
constexpr size_t WS_FW_T = al256(WS_WO_T + (size_t)2 * 1024 * 1024 * 2);
constexpr size_t WS_H = al256(WS_FW_T + (size_t)2 * 1024 * 2048 * 2);
constexpr size_t WS_SS = al256(WS_H + (size_t)NTOK * DM * 2);
constexpr size_t WS_GS = al256(WS_SS + (size_t)12 * NTOK * 4 * 4);
constexpr size_t WS_SHWGU = al256(WS_GS + (size_t)12 * 3 * 1024 * 4);
constexpr size_t WS_SHWDQ = al256(WS_SHWGU + (size_t)8 * 3 * 5632 * 4);
constexpr size_t WS_SHC = al256(WS_SHWDQ + (size_t)2 * 3 * 1024 * 4);
constexpr int KFC = 2304, KFS = 2048, KFY = KFC + KFS;
constexpr size_t WS_DSC = al256(WS_SHC + (size_t)2 * 3 * 4 * 512 * 4);
constexpr size_t WS_DSS = al256(WS_DSC + (size_t)4096 * KFC * 2);
constexpr size_t WS_DC = al256(WS_DSS + (size_t)4096 * KFS * 2);
constexpr size_t WS_CS = al256(WS_DC + (size_t)256 * 512 * 2);
constexpr size_t WS_MIX = al256(WS_CS + (size_t)512 * 256 * 2);
constexpr size_t MX_MODPART = 0;
constexpr size_t MX_ACT = 0;
constexpr size_t MX_CQRAW = 0;
constexpr size_t MX_CQ = al256(MX_CQRAW + (size_t)NTOK * 1024 * 4);
constexpr size_t MX_CKV = al256(MX_CQ + (size_t)NTOK * 512 * 2);
constexpr size_t MX_KPE = al256(MX_CKV + (size_t)KVROWS * 256 * 2);
constexpr size_t MX_Q = al256(MX_KPE + (size_t)KVROWS * 64 * 2);
constexpr size_t MX_KN = al256(MX_Q + (size_t)NTOK * 1536 * 2);
constexpr size_t MX_VT = al256(MX_KN + (size_t)KVROWS * 1024 * 2);
constexpr size_t MX_O = al256(MX_VT + (size_t)KVROWS * 1024 * 2);
constexpr size_t MX_MLA_END = al256(MX_O + (size_t)NTOK * 1024 * 2);
constexpr size_t MX_YF = 0;
constexpr size_t MX_HFC = al256(MX_YF + (size_t)2 * 1024 * KFY * 2);
constexpr size_t MX_HFS = al256(MX_HFC + (size_t)2 * KFC * 1024 * 2);
constexpr size_t MX_YTC = al256(MX_HFS + (size_t)2 * KFS * 1024 * 2);
constexpr size_t MX_F = al256(MX_YTC + (size_t)32 * 1024 * 512 * 2);
constexpr size_t MX_FOU_END = al256(MX_F + (size_t)NTOK * 2048 * 2);
constexpr size_t MX_SIZE = MX_MLA_END > MX_FOU_END ? MX_MLA_END : MX_FOU_END;
constexpr size_t WS_END = WS_MIX + MX_SIZE;
static_assert((size_t)NTOK * DFF * 2 <= MX_SIZE && (size_t)256 * MODL * 4 <= MX_SIZE, "mix region");

#ifndef ATT_SGB
#define ATT_SGB 1
#endif
#ifndef REP_ATTN
#define REP_ATTN 1
#endif
#ifndef REP_NORM
#define REP_NORM 1
#endif
#ifndef REP_PRO
#define REP_PRO 1
#endif
#ifndef REP_GU
#define REP_GU 1
#endif
constexpr int LDS_MISC = 147456;
constexpr int LDS_RED = LDS_MISC + 256;
constexpr int LDS_BYTES = LDS_MISC + 256 + 4096;

struct Params {
    const float *x_prompt, *x_sample, *cache_ckv, *cache_kpe, *c, *c_ctx, *w_mod, *b_mod, *norm_g, *wg, *wu, *wd,
        *w_dq, *q_norm, *w_uq, *w_dkv, *kv_norm, *w_ukv, *w_o, *fw, *fb, *final_norm;
    float* out; unsigned char* ws;
};

DI unsigned cvtpk(float lo, float hi) { f32x2 v = {lo, hi}; bf16x2_t b = __builtin_convertvector(v, bf16x2_t); return __builtin_bit_cast(unsigned, b); }
DI float bf2f(short v) { return __uint_as_float(((unsigned)(unsigned short)v) << 16); }
DI unsigned short f2bf(float f) { return (unsigned short)(cvtpk(f, 0.f) & 0xffffu); }
DI float shx(float v, int lane, int m) { return __int_as_float(__builtin_amdgcn_ds_bpermute((lane ^ m) << 2, __float_as_int(v))); }
DI float wave_sum(float v, int lane) {
#pragma unroll
    for (int o = 1; o < 64; o <<= 1) v += shx(v, lane, o);
    return v;
}
DI float max3f(float a, float b, float c) { float r; asm("v_max3_f32 %0, %1, %2, %3" : "=v"(r) : "v"(a), "v"(b), "v"(c)); return r; }
DI float fmax2f(float a, float b) { float r; asm("v_max_f32_e32 %0, %1, %2" : "=v"(r) : "v"(a), "v"(b)); return r; }
DI float rsq_p4(const float* p) { const f32x4 v = *(const f32x4*)p; return __builtin_amdgcn_rsqf(((v[0] + v[1]) + (v[2] + v[3])) * (1.0f / 1024.0f) + EPS); }
DI float rsq_ss(float ss) { return __builtin_amdgcn_rsqf(ss * (1.0f / 1024.0f) + EPS); }
DI float silu_f(float x) { return x * __builtin_amdgcn_rcpf(1.0f + __builtin_amdgcn_exp2f(-1.4426950408889634f * x)); }
DI int sopq(int v) { asm volatile("" : "+s"(v)); return v; }
DI int opq(int v) { asm volatile("" : "+v"(v)); return v; }
#define LDS_WAIT() asm volatile("s_waitcnt lgkmcnt(0)" ::: "memory")

namespace pg8 {
constexpr int BM = 256, BK = 64, HALF = 128, HTB = HALF * BK * 2, STAGE_BYTES = 8 * HTB, NXCD = 8, WGM = 8;
DI int lds_byte(int r, int c) { const int st = (r >> 4) * 2 + (c >> 5), rr = r & 15, cc = c & 31, ob = rr * 64 + cc * 2; return st * 1024 + (ob ^ (((ob >> 9) & 1) << 5)); }
DI void stage_rc(int b, int& R, int& C) { const int st = b / 1024, sb = b % 1024, swz = sb ^ (((sb >> 9) & 1) << 5); R = (st >> 1) * 16 + swz / 64; C = (st & 1) * 32 + (swz % 64) / 2; }
DI int perm32(int rho) { const int n = rho >> 4, i = rho & 15; return 8 * (i >> 2) + 4 * n + (i & 3); }

struct Unit { int z, pm, pn; };
struct Gemm { const bf16_t* A; const bf16_t* Bt; int lda, ldb, K, nM, nN, nZ; long sAz, sBz; int zsh = 0; long sAy = 0, sBy = 0; };

struct Order {
    int nM, nMz, nN, nwg, G, c;
    DI void init(const Gemm& g, int G_, int c_) { nM = g.nM; nMz = g.nM * g.nZ; nN = g.nN; nwg = nMz * nN; G = G_; c = c_; }
    DI bool next(int i, Unit& u) const {
        const long L = (long)i * G + c; if (L >= nwg) return false;
        int wgid = (int)L; { const int q = nwg / NXCD, r = nwg % NXCD, xcd = wgid % NXCD, off = wgid / NXCD; wgid = (xcd < r ? xcd * (q + 1) : r * (q + 1) + (xcd - r) * q) + off; }
        const int nig = WGM * nN, gid = wgid / nig, fm = gid * WGM, gsz = (nMz - fm) < WGM ? (nMz - fm) : WGM;
        const int pmz = fm + ((wgid % nig) % gsz); u.pn = (wgid % nig) / gsz; u.z = pmz / nM; u.pm = pmz % nM; return true;
    }
};

typedef f32x4 Acc[2][2][4][2];

struct EpiBf16 {
    static constexpr bool PERM = true;
    bf16_t* O; long ldc; long zs; float scale; int zsh = 0; long ys = 0;
    DI void operator()(const Acc& acc, const Unit& u, int wr, int wc, int fr, int fq) const {
        bf16_t* base = O + (size_t)(u.z >> zsh) * zs + (size_t)(u.z & ((1 << zsh) - 1)) * ys + (size_t)(u.pm * BM + wr * 64 + fr) * ldc + u.pn * BM + wc * 32 + 8 * fq;
#pragma unroll
        for (int ai = 0; ai < 2; ++ai)
#pragma unroll
            for (int m = 0; m < 4; ++m) { bf16_t* rowp = base + (size_t)(ai * HALF + m * 16) * ldc;
#pragma unroll
                for (int bj = 0; bj < 2; ++bj) { const f32x4 v0 = acc[ai][bj][m][0] * scale, v1 = acc[ai][bj][m][1] * scale;
                    u32x4 w; w.x = cvtpk(v0[0], v0[1]); w.y = cvtpk(v0[2], v0[3]); w.z = cvtpk(v1[0], v1[1]); w.w = cvtpk(v1[2], v1[3]);
                    *(u32x4*)(rowp + bj * HALF) = w; } }
    }
};
struct EpiYt {
    static constexpr bool PERM = true;
    bf16_t* YtC; bf16_t* YtL; const float* SSp; const float* shc;
    DI void operator()(const Acc& acc, const Unit& u, int wr, int wc, int fr, int fq) const {
        bf16_t* tb; long ldc;
        if (u.pn < 32) { tb = YtC + (size_t)u.pn * 1024 * 512 + (size_t)(u.z * 256) * 512 + u.pm * 256; ldc = 512; }
        else { const int t = (u.pn - 32) * 256, b = t >> 12, s0 = t & 4095; tb = YtL + (size_t)b * 1024 * 8192 + (size_t)(u.z * 256) * 8192 + u.pm * 4096 + s0; ldc = 8192; }
        const int tok0 = u.pn * BM; const int cond = tok0 >= NCTX ? 1 + ((tok0 - NCTX) >> 12) : 0;
        const float* sc = shc + (cond * 4 + u.z) * 512 + u.pm * 256 + wr * 64 + fr;
        f32x4 rsv[2][2];
#pragma unroll
        for (int bj = 0; bj < 2; ++bj)
#pragma unroll
            for (int n = 0; n < 2; ++n) { const float* sp = SSp + (size_t)(tok0 + bj * HALF + wc * 32 + 8 * fq + 4 * n) * 4; rsv[bj][n] = (f32x4){rsq_p4(sp), rsq_p4(sp + 4), rsq_p4(sp + 8), rsq_p4(sp + 12)}; }
        bf16_t* base = tb + (size_t)(wr * 64 + fr) * ldc + wc * 32 + 8 * fq;
#pragma unroll
        for (int ai = 0; ai < 2; ++ai)
#pragma unroll
            for (int m = 0; m < 4; ++m) { bf16_t* rowp = base + (size_t)(ai * HALF + m * 16) * ldc; const float sh = sc[ai * HALF + m * 16];
#pragma unroll
                for (int bj = 0; bj < 2; ++bj) { const f32x4 v0 = acc[ai][bj][m][0] * rsv[bj][0] + sh, v1 = acc[ai][bj][m][1] * rsv[bj][1] + sh;
                    u32x4 w; w.x = cvtpk(v0[0], v0[1]); w.y = cvtpk(v0[2], v0[3]); w.z = cvtpk(v1[0], v1[1]); w.w = cvtpk(v1[2], v1[3]);
                    *(u32x4*)(rowp + bj * HALF) = w; } }
    }
};
struct EpiSwiglu {
    static constexpr bool PERM = true;
    bf16_t* O; const float* SSp; const float* shw;
    DI void operator()(const Acc& acc, const Unit& u, int wr, int wc, int fr, int fq) const {
        const int rowt = u.pm * BM; const int cond = rowt >= NCTX ? 1 + ((rowt - NCTX) >> 12) : 0;
        const float* sw = shw + cond * 5632 + u.pn * BM + wc * 32 + 8 * fq;
        const f32x4 sg0 = *(const f32x4*)sw, sg1 = *(const f32x4*)(sw + 4), su0 = *(const f32x4*)(sw + HALF), su1 = *(const f32x4*)(sw + HALF + 4);
        const float* ssr = SSp + (size_t)(rowt + wr * 64 + fr) * 4;
        bf16_t* base = O + (size_t)(u.pm * BM + wr * 64 + fr) * DFF + u.pn * HALF + wc * 32 + 8 * fq;
#pragma unroll
        for (int ai = 0; ai < 2; ++ai)
#pragma unroll
            for (int m = 0; m < 4; ++m) { bf16_t* rowp = base + (size_t)(ai * HALF + m * 16) * DFF; const float rs = rsq_p4(ssr + (ai * HALF + m * 16) * 4);
                const f32x4 g0 = acc[ai][0][m][0] * rs + sg0, g1 = acc[ai][0][m][1] * rs + sg1, u0 = acc[ai][1][m][0] * rs + su0, u1 = acc[ai][1][m][1] * rs + su1;
                float v[8];
#pragma unroll
                for (int j = 0; j < 4; ++j) { v[j] = silu_f(g0[j]) * u0[j]; v[4 + j] = silu_f(g1[j]) * u1[j]; }
                u32x4 w; w.x = cvtpk(v[0], v[1]); w.y = cvtpk(v[2], v[3]); w.z = cvtpk(v[4], v[5]); w.w = cvtpk(v[6], v[7]);
                *(u32x4*)rowp = w; }
    }
};
struct EpiF32 {
    static constexpr bool PERM = false;
    float* O; const float* SSp; const float* shw;
    DI void operator()(const Acc& acc, const Unit& u, int wr, int wc, int fr, int fq) const {
        const int rowt = u.pm * BM; const int cond = rowt >= NCTX ? 1 + ((rowt - NCTX) >> 12) : 0;
        const float* sw = shw + cond * 1024 + u.pn * BM + wc * 32 + 4 * fq;
        f32x4 sv[2][2];
#pragma unroll
        for (int bj = 0; bj < 2; ++bj)
#pragma unroll
            for (int n = 0; n < 2; ++n) sv[bj][n] = *(const f32x4*)(sw + bj * HALF + n * 16);
        const float* ssr = SSp + (size_t)(rowt + wr * 64 + fr) * 4;
        float* base = O + (size_t)(u.pm * BM + wr * 64 + fr) * 1024 + u.pn * BM + wc * 32 + 4 * fq;
#pragma unroll
        for (int ai = 0; ai < 2; ++ai)
#pragma unroll
            for (int m = 0; m < 4; ++m) { float* rowp = base + (size_t)(ai * HALF + m * 16) * 1024; const float rs = rsq_p4(ssr + (ai * HALF + m * 16) * 4);
#pragma unroll
                for (int bj = 0; bj < 2; ++bj)
#pragma unroll
                    for (int n = 0; n < 2; ++n) *(f32x4*)(rowp + bj * HALF + n * 16) = acc[ai][bj][m][n] * rs + sv[bj][n]; }
    }
};
struct EpiResid {
    static constexpr bool PERM = true;
    const float* xlo; const float* xhi; float* out; const float* coef; const float* bias; bf16_t* Hs; const float* gsn; float* ssn; LAS unsigned char* lds; float cmul; int wh_;
    DI void operator()(Acc& acc, const Unit& u, int wr, int wc, int fr, int fq) const {
        const int rowt = u.pm * BM; const bool hi = rowt >= NCTX;
        const int cond = hi ? 1 + ((rowt - NCTX) >> 12) : 0;
        const float* cf = coef + cond * NMODC;
        const float* xb = hi ? xhi + (size_t)(rowt - NCTX) * 1024 : xlo + (size_t)rowt * 1024;
        float* ob = out + (size_t)rowt * 1024;
        const int col0 = u.pn * BM + wc * 32 + 8 * fq;
        const bool wh = wh_ != 0;
        LAS float* red = (LAS float*)(lds + LDS_RED);
        if (bias) {
#pragma unroll
            for (int bj = 0; bj < 2; ++bj)
#pragma unroll
                for (int n = 0; n < 2; ++n) { const f32x4 b4 = *(const f32x4*)(bias + col0 + bj * HALF + n * 4);
#pragma unroll
                    for (int ai = 0; ai < 2; ++ai)
#pragma unroll
                        for (int m = 0; m < 4; ++m) acc[ai][bj][m][n] += b4; }
        }
        f32x4 cv[2][2], gv[2][2];
#pragma unroll
        for (int bj = 0; bj < 2; ++bj)
#pragma unroll
            for (int n = 0; n < 2; ++n) { const int cc = col0 + bj * HALF + n * 4; cv[bj][n] = *(const f32x4*)(cf + cc) * cmul;
                gv[bj][n] = wh ? *(const f32x4*)(gsn + cond * 1024 + cc) : (f32x4){0.f, 0.f, 0.f, 0.f}; }
#pragma unroll
        for (int ai = 0; ai < 2; ++ai)
#pragma unroll
            for (int m = 0; m < 4; ++m) { const int rl = ai * HALF + wr * 64 + m * 16 + fr; const size_t roff = (size_t)rl * 1024 + col0; float sq = 0.f;
#pragma unroll
                for (int bj = 0; bj < 2; ++bj) { const size_t off = roff + bj * HALF;
                    const f32x4 x0 = *(const f32x4*)(xb + off), x1 = *(const f32x4*)(xb + off + 4);
                    const f32x4 o0 = x0 + cv[bj][0] * acc[ai][bj][m][0], o1 = x1 + cv[bj][1] * acc[ai][bj][m][1];
                    *(f32x4*)(ob + off) = o0; *(f32x4*)(ob + off + 4) = o1;
                    if (wh) { sq += ((o0[0] * o0[0] + o0[1] * o0[1]) + (o0[2] * o0[2] + o0[3] * o0[3])) + ((o1[0] * o1[0] + o1[1] * o1[1]) + (o1[2] * o1[2] + o1[3] * o1[3]));
                        const f32x4 h0 = o0 * gv[bj][0], h1 = o1 * gv[bj][1];
                        u32x4 w; w.x = cvtpk(h0[0], h0[1]); w.y = cvtpk(h0[2], h0[3]); w.z = cvtpk(h1[0], h1[1]); w.w = cvtpk(h1[2], h1[3]);
                        *(u32x4*)(Hs + (size_t)rowt * 1024 + off) = w; } }
                if (wh) { const int ln = fq * 16 + fr; sq += shx(sq, ln, 16); sq += shx(sq, ln, 32); if (fq == 0) red[rl * 4 + wc] = sq; } }
        if (wh) {
            asm volatile("s_waitcnt lgkmcnt(0)" ::: "memory"); __builtin_amdgcn_s_barrier(); asm volatile("" ::: "memory");
            const int t = wr * 256 + wc * 64 + fq * 16 + fr;
            if (t < 256) { const f32x4 p = *(const LAS f32x4*)(red + t * 4); ssn[(size_t)(rowt + t) * 4 + u.pn] = (p[0] + p[1]) + (p[2] + p[3]); }
        }
    }
};

template <class Epi>
DI void gemm_phase(LAS unsigned char* lds, const Gemm g, const Order& S, const Epi& E) {
    const int tid = opq(threadIdx.x), wid = __builtin_amdgcn_readfirstlane(tid >> 6), lane = tid & 63, wr = wid >> 2, wc = wid & 3, fr = lane & 15, fq = lane >> 4;
    const int K = g.K, nt = K / BK;
    unsigned voffA[2], voffB[2];
#pragma unroll
    for (int i = 0; i < 2; ++i) { int R, C; stage_rc(tid * 16 + i * 8192, R, C); const int Rb = Epi::PERM ? ((R & ~31) + perm32(R & 31)) : R;
        voffA[i] = (unsigned)(R * g.lda + C) * 2u; voffB[i] = (unsigned)(Rb * g.ldb + C) * 2u; }
    const size_t kstep = (size_t)(BK * 2);
    const size_t hstepA = (size_t)HALF * g.lda * 2, hstepB = (size_t)HALF * g.ldb * 2;
    const unsigned ldsw = (unsigned)wid * 1024u;
    const int aoff = lds_byte(wr * 64 + fr, fq * 8), boff = lds_byte(wc * 32 + fr, fq * 8);
#define PG8_UA(u) ((const char*)g.A + ((size_t)((u).z >> g.zsh) * g.sAz + (size_t)((u).z & ((1 << g.zsh) - 1)) * g.sAy + (size_t)(u).pm * BM * g.lda) * 2)
#define PG8_UB(u) ((const char*)g.Bt + ((size_t)((u).z >> g.zsh) * g.sBz + (size_t)((u).z & ((1 << g.zsh) - 1)) * g.sBy + (size_t)(u).pn * BM * g.ldb) * 2)
#define PG8_SA(b, h) (((b) * 2 + (h)) * HTB)
#define PG8_SB(b, h) ((4 + (b) * 2 + (h)) * HTB)
#define PG8_STAGE(bufoff, gbase, voff) do { _Pragma("unroll") for (int _i = 0; _i < 2; ++_i) \
        __builtin_amdgcn_global_load_lds((const unsigned*)((const char*)(gbase) + (voff)[_i]), (LAS unsigned*)(lds + (bufoff) + ldsw + _i * 8192), 16, 0, 0); } while (0)
#define PG8_LDA(dst, b, h) do { _Pragma("unroll") for (int m = 0; m < 4; ++m) _Pragma("unroll") for (int k = 0; k < 2; ++k) dst[m][k] = *(const LAS bf16x8*)(lds + PG8_SA(b, h) + aoff + m * 2048 + k * 1024); } while (0)
#define PG8_LDB(dst, b, h) do { _Pragma("unroll") for (int n = 0; n < 2; ++n) _Pragma("unroll") for (int k = 0; k < 2; ++k) dst[n][k] = *(const LAS bf16x8*)(lds + PG8_SB(b, h) + boff + n * 2048 + k * 1024); } while (0)
#define PG8_MMA(ai, bj, At, Bt) do { __builtin_amdgcn_s_setprio(1); _Pragma("unroll") for (int m = 0; m < 4; ++m) _Pragma("unroll") for (int n = 0; n < 2; ++n) _Pragma("unroll") for (int k = 0; k < 2; ++k) \
        acc[ai][bj][m][n] = __builtin_amdgcn_mfma_f32_16x16x32_bf16(Bt[n][k], At[m][k], acc[ai][bj][m][n], 0, 0, 0); __builtin_amdgcn_s_setprio(0); } while (0)
#define PG8_WAIT_V(n) asm volatile("s_waitcnt vmcnt(" #n ")" ::: "memory")
#define PG8_WAIT_L(n) asm volatile("s_waitcnt lgkmcnt(" #n ")" ::: "memory")
#define PG8_BAR __builtin_amdgcn_s_barrier()
#define PG8_SCHED __builtin_amdgcn_sched_barrier(0)
    Unit cur, nxt; int ui = 0;
    if (!S.next(0, cur)) return;
    Acc acc;
#pragma unroll
    for (int a = 0; a < 2; ++a)
#pragma unroll
        for (int b = 0; b < 2; ++b)
#pragma unroll
            for (int m = 0; m < 4; ++m)
#pragma unroll
                for (int n = 0; n < 2; ++n) acc[a][b][m][n] = (f32x4){0.f, 0.f, 0.f, 0.f};
    bf16x8 At[4][2], B0[2][2], B1[2][2];
    const char* cA = PG8_UA(cur); const char* cB = PG8_UB(cur);
    PG8_STAGE(PG8_SB(0, 0), cB, voffB); PG8_STAGE(PG8_SB(0, 1), cB + hstepB, voffB); PG8_STAGE(PG8_SA(0, 0), cA, voffA); PG8_STAGE(PG8_SA(0, 1), cA + hstepA, voffA);
    if (wr == 1) PG8_BAR;
    PG8_WAIT_V(2); PG8_BAR;
    PG8_STAGE(PG8_SB(1, 0), cB + kstep, voffB); PG8_STAGE(PG8_SA(1, 0), cA + kstep, voffA); PG8_STAGE(PG8_SB(1, 1), cB + hstepB + kstep, voffB);
    PG8_WAIT_V(6); PG8_BAR;
    for (;;) {
        const bool has_next = S.next(ui + 1, nxt);
        const char* nA = has_next ? PG8_UA(nxt) : cA; const char* nB = has_next ? PG8_UB(nxt) : cB;
        for (int t = 0; t < nt; t += 2) {
            const bool last = (t == nt - 2);
            const char* a1 = cA + (size_t)(t + 1) * kstep;
            const char* a2 = last ? nA : cA + (size_t)(t + 2) * kstep; const char* b2 = last ? nB : cB + (size_t)(t + 2) * kstep;
            const char* a3 = a2 + kstep; const char* b3 = b2 + kstep;
            PG8_LDB(B0, 0, 0); PG8_LDB(B1, 0, 1); PG8_SCHED; PG8_LDA(At, 0, 0); PG8_STAGE(PG8_SA(1, 1), a1 + hstepA, voffA);
            PG8_WAIT_V(8); PG8_WAIT_L(0); PG8_BAR; PG8_MMA(0, 0, At, B0); PG8_MMA(0, 1, At, B1); PG8_BAR; PG8_SCHED;
            PG8_LDA(At, 0, 1); PG8_STAGE(PG8_SB(0, 0), b2, voffB); PG8_STAGE(PG8_SB(0, 1), b2 + hstepB, voffB); PG8_STAGE(PG8_SA(0, 0), a2, voffA);
            PG8_WAIT_V(8); PG8_WAIT_L(0); PG8_BAR; PG8_MMA(1, 0, At, B0); PG8_MMA(1, 1, At, B1); PG8_BAR; PG8_SCHED;
            PG8_LDB(B0, 1, 0); PG8_LDB(B1, 1, 1); PG8_SCHED; PG8_LDA(At, 1, 0); PG8_STAGE(PG8_SA(0, 1), a2 + hstepA, voffA);
            PG8_WAIT_V(8); PG8_WAIT_L(0); PG8_BAR; PG8_MMA(0, 0, At, B0); PG8_MMA(0, 1, At, B1); PG8_BAR; PG8_SCHED;
            PG8_LDA(At, 1, 1); PG8_STAGE(PG8_SB(1, 0), b3, voffB); PG8_STAGE(PG8_SB(1, 1), b3 + hstepB, voffB); PG8_STAGE(PG8_SA(1, 0), a3, voffA);
            PG8_WAIT_V(8); PG8_WAIT_L(0); PG8_BAR; PG8_MMA(1, 0, At, B0); PG8_MMA(1, 1, At, B1); PG8_BAR; PG8_SCHED;
        }
        if (wr == 0) PG8_BAR;
        E(acc, cur, wr, wc, fr, fq);
        if (!has_next) break;
#pragma unroll
        for (int a = 0; a < 2; ++a)
#pragma unroll
            for (int b = 0; b < 2; ++b)
#pragma unroll
                for (int m = 0; m < 4; ++m)
#pragma unroll
                    for (int n = 0; n < 2; ++n) acc[a][b][m][n] = (f32x4){0.f, 0.f, 0.f, 0.f};
        cur = nxt; cA = nA; cB = nB; ++ui;
        if (wr == 1) PG8_BAR;
    }
    PG8_WAIT_V(0);
    PG8_BAR;
#undef PG8_UA
#undef PG8_UB
#undef PG8_SA
#undef PG8_SB
#undef PG8_STAGE
#undef PG8_LDA
#undef PG8_LDB
#undef PG8_MMA
#undef PG8_WAIT_V
#undef PG8_WAIT_L
#undef PG8_BAR
#undef PG8_SCHED
}
}

struct AttnT { const bf16_t* Q; const bf16_t* KN; const bf16_t* KPE; const bf16_t* VT; bf16_t* O; const float* rope; };
constexpr int AK_ROW = 384, AK_BUF = 64 * AK_ROW, AV_ROW = 128, AV_BUF = 128 * AV_ROW, AV_OFF = 4 * AK_BUF;
static_assert(AV_OFF + 3 * AV_BUF <= LDS_MISC, "attention LDS");

DI void attn_unit(LAS unsigned char* lds, const AttnT& T, int qrow0, int h, int kv0, int nk, int pos0, bool rope) {
    const int tid = opq(threadIdx.x), lane = tid & 63, wid = tid >> 6, r = lane & 31, h2 = lane >> 5;
    const int pr = (r & ~12) | ((r & 4) << 1) | ((r & 8) >> 1);
    bf16x8 qf[12];
    { const bf16_t* qp = T.Q + (size_t)(qrow0 + 32 * wid + r) * 1536 + h * 192 + 8 * h2;
#pragma unroll
      for (int ks = 0; ks < 12; ++ks) qf[ks] = *(const bf16x8*)(qp + 16 * ks); }
    if (rope) {
        const int pos = pos0 + 32 * wid + r;
#pragma unroll
        for (int a = 0; a < 2; ++a) {
            const int idx = a ? (pos & 63) : (pos >> 6);
            const float* cs = T.rope + idx * 16 + 8 * h2;
            const f32x4 c0 = *(const f32x4*)cs, c1 = *(const f32x4*)(cs + 4), s0 = *(const f32x4*)(cs + 1024), s1 = *(const f32x4*)(cs + 1028);
            bf16x8 x1 = qf[8 + 2 * a], x2 = qf[9 + 2 * a], o1, o2;
#pragma unroll
            for (int j = 0; j < 8; ++j) { const float cc = j < 4 ? c0[j & 3] : c1[j & 3], sn = j < 4 ? s0[j & 3] : s1[j & 3];
                const float a1 = bf2f(x1[j]), a2 = bf2f(x2[j]);
                o1[j] = (short)f2bf(a1 * cc - a2 * sn); o2[j] = (short)f2bf(a2 * cc + a1 * sn); }
            qf[8 + 2 * a] = o1; qf[9 + 2 * a] = o2;
        }
    }
    const char* gk[3]; unsigned skb[3];
#pragma unroll
    for (int j = 0; j < 3; ++j) { const int c = (wid * 3 + j) * 64 + lane, row = c / 24, pc = c - row * 24, lc = pc ^ ((row >> 1) & 7);
        const bool nope = lc < 16;
        gk[j] = nope ? (const char*)(T.KN + (size_t)(kv0 + row) * 1024 + h * 128 + lc * 8) : (const char*)(T.KPE + (size_t)(kv0 + row) * 64 + (lc - 16) * 8);
        skb[j] = nope ? 64u * 1024u * 2u : 64u * 64u * 2u; }
    const char* gv[2];
#pragma unroll
    for (int j = 0; j < 2; ++j) { const int c = (wid * 2 + j) * 64 + lane, row = c >> 3, lc = (c & 7) ^ ((row >> 1) & 7);
        gv[j] = (const char*)(T.VT + (size_t)(h * 128 + row) * KVROWS + kv0 + lc * 8); }
    const int wid_u = __builtin_amdgcn_readfirstlane(wid);
#define ATT_DMA_K(t, slot) do { _Pragma("unroll") for (int j_ = 0; j_ < 3; ++j_) \
        __builtin_amdgcn_global_load_lds((const unsigned*)(gk[j_] + (size_t)(t) * skb[j_]), (LAS unsigned*)(lds + (slot) * AK_BUF + (wid_u * 3 + j_) * 1024), 16, 0, 0); } while (0)
#define ATT_DMA_V(t, slot) do { _Pragma("unroll") for (int j_ = 0; j_ < 2; ++j_) \
        __builtin_amdgcn_global_load_lds((const unsigned*)(gv[j_] + (size_t)(t) * 128), (LAS unsigned*)(lds + AV_OFF + (slot) * AV_BUF + (wid_u * 2 + j_) * 1024), 16, 0, 0); } while (0)
#define ATT_WAIT_V(n) asm volatile("s_waitcnt vmcnt(" #n ")" ::: "memory")
#define ATT_BAR() do { __builtin_amdgcn_s_barrier(); asm volatile("" ::: "memory"); } while (0)
    const int kswz = (pr >> 1) & 7, vswz = (r >> 1) & 7;
    int kco[4], vco[4];
#pragma unroll
    for (int j = 0; j < 4; ++j) { kco[j] = pr * AK_ROW + (((2 * j + h2) ^ kswz) << 4); vco[j] = AV_OFF + r * AV_ROW + (((2 * j + h2) ^ vswz) << 4); }
#define ATT_KF(slotbase, kb2, ks) (*(const LAS bf16x8*)((slotbase) + (kb2) * 32 * AK_ROW + kco[(ks) & 3] + ((ks) >> 2) * 128))
    f32x16 o[4];
#pragma unroll
    for (int d = 0; d < 4; ++d)
#pragma unroll
        for (int i = 0; i < 16; ++i) o[d][i] = 0.f;
    float mrun = -1e30f, lrun = 0.f;
    const int ntile = nk >> 6, tlast = ntile - 1;
    ATT_DMA_K(0, 0); ATT_DMA_V(0, 0); ATT_DMA_K(1 < tlast ? 1 : tlast, 1);
    ATT_DMA_K(2 < tlast ? 2 : tlast, 2); ATT_DMA_V(1 < tlast ? 1 : tlast, 1);
    ATT_WAIT_V(5); ATT_BAR();
    f32x16 s0, s1;
#pragma unroll
    for (int i = 0; i < 16; ++i) { s0[i] = 0.f; s1[i] = 0.f; }
    { const LAS unsigned char* kb_ = lds;
#pragma unroll
      for (int ks = 0; ks < 12; ++ks) { const bf16x8 k0_ = ATT_KF(kb_, 0, ks), k1_ = ATT_KF(kb_, 1, ks);
          s0 = __builtin_amdgcn_mfma_f32_32x32x16_bf16(k0_, qf[ks], s0, 0, 0, 0); s1 = __builtin_amdgcn_mfma_f32_32x32x16_bf16(k1_, qf[ks], s1, 0, 0, 0); } }
    int ksl = 1, vsl = 0;
    for (int t = 0; t < ntile; ++t) {
        { const int tk = t + 3 < tlast ? t + 3 : tlast, tv = t + 2 < tlast ? t + 2 : tlast;
          const int kd = (ksl + 2) & 3, vd = vsl + 2 >= 3 ? vsl - 1 : vsl + 2; ATT_DMA_K(tk, kd); ATT_DMA_V(tv, vd); }
        f32x16 n0, n1;
#pragma unroll
        for (int i = 0; i < 16; ++i) { n0[i] = 0.f; n1[i] = 0.f; }
        const LAS unsigned char* kb_ = lds + ksl * AK_BUF;
        bf16x8 ka0 = ATT_KF(kb_, 0, 0), ka1 = ATT_KF(kb_, 1, 0), kn0 = ATT_KF(kb_, 0, 1), kn1 = ATT_KF(kb_, 1, 1);
        float mx = 0.f, oth = 0.f, mnew = 0.f, alpha = 1.f, ps = 0.f;
#define SEL(e) ((e) < 16 ? s0[(e) & 15] : s1[(e) & 15])
#define PEXP(e) do { const float p_ = __builtin_amdgcn_exp2f(SEL(e) - mnew); if ((e) < 16) s0[(e) & 15] = p_; else s1[(e) & 15] = p_; ps += p_; } while (0)
#pragma unroll
        for (int ks = 0; ks < 12; ++ks) {
            bf16x8 kf0 = kn0, kf1 = kn1;
            if (ks < 10) { kf0 = ATT_KF(kb_, 0, ks + 2); kf1 = ATT_KF(kb_, 1, ks + 2); }
            n0 = __builtin_amdgcn_mfma_f32_32x32x16_bf16(ka0, qf[ks], n0, 0, 0, 0);
            n1 = __builtin_amdgcn_mfma_f32_32x32x16_bf16(ka1, qf[ks], n1, 0, 0, 0);
            if (ks == 0) { mx = max3f(s0[0], s0[1], s0[2]);
#pragma unroll
                for (int i = 3; i < 15; i += 2) mx = max3f(mx, s0[i], s0[i + 1]);
                mx = max3f(mx, s0[15], s1[0]); }
            if (ks == 1) {
#pragma unroll
                for (int i = 1; i < 15; i += 2) mx = max3f(mx, s1[i], s1[i + 1]);
                mx = fmax2f(mx, s1[15]); oth = shx(mx, lane, 32); }
            if (ks == 2) { mnew = max3f(mrun, mx, oth); alpha = __builtin_amdgcn_exp2f(mrun - mnew); mrun = mnew; PEXP(0); PEXP(1); }
            if (ks >= 3 && ks <= 9) { PEXP(2 + 4 * (ks - 3)); PEXP(3 + 4 * (ks - 3)); PEXP(4 + 4 * (ks - 3)); PEXP(5 + 4 * (ks - 3)); }
            if (ks == 10) { PEXP(30); PEXP(31); lrun = lrun * alpha + ps; }
            if (ks == 11) {
#pragma unroll
                for (int d = 0; d < 4; ++d) o[d] = o[d] * alpha; }
            __builtin_amdgcn_sched_barrier(0);
            ka0 = kn0; ka1 = kn1; kn0 = kf0; kn1 = kf1;
        }
#undef SEL
#undef PEXP
        bf16x8 pf[4];
#pragma unroll
        for (int s = 0; s < 2; ++s) {
            u32x4 p; p.x = cvtpk(s0[8 * s], s0[8 * s + 1]); p.y = cvtpk(s0[8 * s + 2], s0[8 * s + 3]); p.z = cvtpk(s0[8 * s + 4], s0[8 * s + 5]); p.w = cvtpk(s0[8 * s + 6], s0[8 * s + 7]);
            pf[s] = __builtin_bit_cast(bf16x8, p);
            u32x4 q; q.x = cvtpk(s1[8 * s], s1[8 * s + 1]); q.y = cvtpk(s1[8 * s + 2], s1[8 * s + 3]); q.z = cvtpk(s1[8 * s + 4], s1[8 * s + 5]); q.w = cvtpk(s1[8 * s + 6], s1[8 * s + 7]);
            pf[2 + s] = __builtin_bit_cast(bf16x8, q);
        }
        const LAS unsigned char* vb = lds + vsl * AV_BUF;
        bf16x8 va[4], vn[4];
#pragma unroll
        for (int d = 0; d < 4; ++d) va[d] = *(const LAS bf16x8*)(vb + d * 32 * AV_ROW + vco[0]);
#pragma unroll
        for (int j = 0; j < 4; ++j) {
#pragma unroll
            for (int d = 0; d < 4; ++d) vn[d] = (j < 3) ? *(const LAS bf16x8*)(vb + d * 32 * AV_ROW + vco[(j + 1) & 3]) : va[d];
#pragma unroll
            for (int d = 0; d < 4; ++d) o[d] = __builtin_amdgcn_mfma_f32_32x32x16_bf16(va[d], pf[j], o[d], 0, 0, 0);
            __builtin_amdgcn_sched_barrier(0);
#pragma unroll
            for (int d = 0; d < 4; ++d) va[d] = vn[d];
        }
        asm volatile("s_waitcnt lgkmcnt(0)" ::: "memory"); ATT_WAIT_V(5); ATT_BAR();
        s0 = n0; s1 = n1;
        ksl = (ksl + 1) & 3; vsl = vsl + 1 >= 3 ? 0 : vsl + 1;
    }
    ATT_WAIT_V(0); ATT_BAR();
    const float ltot = lrun + shx(lrun, lane, 32);
    const float inv = 1.0f / ltot;
    bf16_t* op = T.O + (size_t)(qrow0 + 32 * wid + r) * 1024 + h * 128 + 4 * h2;
#pragma unroll
    for (int d = 0; d < 4; ++d)
#pragma unroll
        for (int gq = 0; gq < 4; ++gq) {
            u32x2 w; w.x = cvtpk(o[d][4 * gq] * inv, o[d][4 * gq + 1] * inv); w.y = cvtpk(o[d][4 * gq + 2] * inv, o[d][4 * gq + 3] * inv);
            *(u32x2*)(op + 32 * d + 8 * gq) = w;
        }
#undef ATT_DMA_K
#undef ATT_DMA_V
#undef ATT_WAIT_V
#undef ATT_BAR
#undef ATT_KF
}

DI void transpose_item(const float* W, int N, bf16_t* WT, int ldt, int dst_row0, LAS float* scr, int k0, int n0, int lane_) {
    const int lane = opq(lane_);
    f32x4 v[8];
    const float* wp = W + (size_t)(k0 + (lane >> 3)) * N + n0 + (lane & 7) * 4;
#pragma unroll
    for (int i = 0; i < 8; ++i) v[i] = __builtin_nontemporal_load((const f32x4*)(wp + (size_t)(8 * i) * N));
#pragma unroll
    for (int i = 0; i < 8; ++i) { LAS float* s = scr + (8 * i + (lane >> 3)) * 33 + (lane & 7) * 4; s[0] = v[i][0]; s[1] = v[i][1]; s[2] = v[i][2]; s[3] = v[i][3]; }
    LDS_WAIT();
    const int c = lane & 7;
#pragma unroll
    for (int j = 0; j < 4; ++j) { const int n = (lane >> 3) + 8 * j; const LAS float* s = scr + (8 * c) * 33 + n;
        u32x4 o; o.x = cvtpk(s[0 * 33], s[1 * 33]); o.y = cvtpk(s[2 * 33], s[3 * 33]); o.z = cvtpk(s[4 * 33], s[5 * 33]); o.w = cvtpk(s[6 * 33], s[7 * 33]);
        *(u32x4*)(WT + (size_t)(dst_row0 + n) * ldt + k0 + 8 * c) = o; }
    LDS_WAIT();
}

DI void sincos2pi(double frac, float& cs, float& sn) {
    const double rr = frac - __builtin_rint(frac);
    const double x = rr * 6.283185307179586476925286766559, x2 = x * x;
    double c = 1.0, s = x, tc = 1.0, ts = x;
#pragma unroll 1
    for (int k = 1; k <= 14; ++k) { tc = -tc * x2 / (double)((2 * k - 1) * (2 * k)); ts = -ts * x2 / (double)((2 * k) * (2 * k + 1)); c += tc; s += ts; }
    cs = (float)c; sn = (float)s;
}

DI void first_norm(const float* xlo, const float* xhi, const float* g, const float* mod, bf16_t* H, float* SS, int gw, int ngw, int lane_) {
    const int lane = opq(lane_);
    for (int rb = gw; rb < NTOK / 8; rb += ngw) {
        const int row0 = rb * 8; const bool hi = row0 >= NCTX; const int cond = hi ? 1 + ((row0 - NCTX) >> 12) : 0;
        const float* mc = mod + cond * NMODC;
        f32x4 gs[4];
#pragma unroll
        for (int j = 0; j < 4; ++j) { const int col = 4 * lane + 256 * j; gs[j] = *(const f32x4*)(g + col) * (*(const f32x4*)(mc + 1024 + col) + 1.0f); }
#pragma unroll 2
        for (int i = 0; i < 8; ++i) {
            const int row = row0 + i;
            const float* xr = hi ? xhi + (size_t)(row - NCTX) * 1024 : xlo + (size_t)row * 1024;
            f32x4 v[4]; float ss = 0.f;
#pragma unroll
            for (int j = 0; j < 4; ++j) { v[j] = *(const f32x4*)(xr + 4 * lane + 256 * j); ss += (v[j].x * v[j].x + v[j].y * v[j].y) + (v[j].z * v[j].z + v[j].w * v[j].w); }
            ss = wave_sum(ss, lane);
            if (lane == 0) *(f32x4*)(SS + (size_t)row * 4) = (f32x4){ss, 0.f, 0.f, 0.f};
            bf16_t* hr = H + (size_t)row * 1024 + 4 * lane;
#pragma unroll
            for (int j = 0; j < 4; ++j) { const f32x4 y = v[j] * gs[j]; u32x2 w; w.x = cvtpk(y.x, y.y); w.y = cvtpk(y.z, y.w); *(u32x2*)(hr + 256 * j) = w; }
        }
    }
}
DI void shw_rows(const bf16_t* W, int nrows, const float* sh, float* out, int ostride, int gw, int ngw, int lane_) {
    const int lane = opq(lane_);
    f32x4 s[3][4];
#pragma unroll
    for (int c = 0; c < 3; ++c)
#pragma unroll
        for (int j = 0; j < 2; ++j) { s[c][2 * j] = *(const f32x4*)(sh + c * NMODC + 8 * lane + 512 * j); s[c][2 * j + 1] = *(const f32x4*)(sh + c * NMODC + 8 * lane + 512 * j + 4); }
    for (int n = gw; n < nrows; n += ngw) {
        const bf16_t* wr = W + (size_t)n * 1024 + 8 * lane;
        float a0 = 0.f, a1 = 0.f, a2 = 0.f;
#pragma unroll
        for (int j = 0; j < 2; ++j) { const bf16x8 w = *(const bf16x8*)(wr + 512 * j);
#pragma unroll
            for (int e = 0; e < 8; ++e) { const float wf = bf2f(w[e]); a0 += wf * s[0][2 * j + (e >> 2)][e & 3]; a1 += wf * s[1][2 * j + (e >> 2)][e & 3]; a2 += wf * s[2][2 * j + (e >> 2)][e & 3]; } }
        a0 = wave_sum(a0, lane); a1 = wave_sum(a1, lane); a2 = wave_sum(a2, lane);
        if (lane == 0) { out[n] = a0; out[ostride + n] = a1; out[2 * ostride + n] = a2; }
    }
}

#define XB_TMO      128
#define XB_XCNT(j)  (256  + 64 * (j))
#define XB_XSUB(j)  (1280 + 64 * (j))
#define XB_XGEN(j)  (2304 + 64 * (j))
#define XB_TOP      3328
#define XB_TOPGEN   3392
#define XCD_BAR_WORDS 3456
#define XB_SPIN_CAP (1u << 18)
static_assert(XCD_BAR_WORDS * 4 <= (int)BAR_BYTES, "barrier words inside the memset region");
DI unsigned xb_ld(unsigned* p)              { return __hip_atomic_load(p, __ATOMIC_RELAXED, __HIP_MEMORY_SCOPE_AGENT); }
DI unsigned xb_add(unsigned* p, unsigned v) { return __hip_atomic_fetch_add(p, v, __ATOMIC_RELAXED, __HIP_MEMORY_SCOPE_AGENT); }
DI unsigned xb_xcc_id() { return (unsigned)__builtin_amdgcn_s_getreg((3 << 11) | 20) & 0xFu; }
#define XB_SPIN(cond, bar) do { unsigned _sp = 0; while (cond) { __builtin_amdgcn_s_sleep(1); \
    if ((++_sp & 255u) == 0u) { if (xb_ld(&(bar)[XB_TMO])) break; if (_sp > XB_SPIN_CAP) { atomicAdd(&(bar)[XB_TMO], 1u); break; } } } } while (0)
struct XcdBarrier { unsigned* bar; unsigned x; volatile LAS unsigned* st; };
DI void xcd_barrier_complete(unsigned* bar, unsigned x, unsigned& nloc, unsigned& nx) {
    const unsigned G = gridDim.x * gridDim.y * gridDim.z;
    unsigned sum, cnt, mine, sp = 0u;
    for (;;) {
        sum = 0u; cnt = 0u; mine = 0u;
#pragma unroll
        for (unsigned j = 0; j < 16; ++j) { const unsigned c = xb_ld(&bar[XB_XCNT(j)]); sum += c; cnt += (c > 0u) ? 1u : 0u; mine = (j == x) ? c : mine; }
        if (sum == G) break;
        __builtin_amdgcn_s_sleep(1);
        if ((++sp & 255u) == 0u) { if (xb_ld(&bar[XB_TMO])) break; if (sp > XB_SPIN_CAP) { atomicAdd(&bar[XB_TMO], 1u); break; } }
    }
    nloc = mine > 0u ? mine : 1u; nx = cnt > 0u ? cnt : 1u;
}
DI void xcd_barrier(const XcdBarrier& b) {
    asm volatile("s_waitcnt vmcnt(0)" ::: "memory");
    __syncthreads();
    if (threadIdx.x == 0) {
        unsigned* bar = b.bar;
        __builtin_amdgcn_s_waitcnt(0);
        unsigned nloc = b.st[0], nx = b.st[1];
        if (nloc == 0u) { xcd_barrier_complete(bar, b.x, nloc, nx); b.st[0] = nloc; b.st[1] = nx; }
        const unsigned old = xb_add(&bar[XB_XSUB(b.x)], 1u);
        const unsigned gen = old / nloc;
        if (old + 1u == (gen + 1u) * nloc) {
            __builtin_amdgcn_fence(__ATOMIC_RELEASE, "agent");
            asm volatile("s_waitcnt vmcnt(0)" ::: "memory");
            const unsigned og = xb_add(&bar[XB_TOP], 1u);
            const unsigned tg = og / nx;
            if (og + 1u == (tg + 1u) * nx) xb_add(&bar[XB_TOPGEN], 1u);
            else XB_SPIN(xb_ld(&bar[XB_TOPGEN]) == tg, bar);
            __builtin_amdgcn_fence(__ATOMIC_ACQUIRE, "agent");
            xb_add(&bar[XB_XGEN(b.x)], 1u);
            asm volatile("s_waitcnt vmcnt(0)" ::: "memory");
        } else {
            XB_SPIN(xb_ld(&bar[XB_XGEN(b.x)]) == gen, bar);
            __builtin_amdgcn_fence(__ATOMIC_ACQUIRE, "agent");
            asm volatile("s_waitcnt vmcnt(0)" ::: "memory");
        }
    }
    __syncthreads();
}
#define GRID_BAR() do { XcdBarrier _b; _b.bar = (unsigned*)(kparams()->ws + WS_BAR); _b.x = xb_xcc_id(); _b.st = (volatile LAS unsigned*)(lds + LDS_MISC); xcd_barrier(_b); } while (0)

typedef const __attribute__((address_space(4))) Params* KP;
DI KP kparams() { KP p = (KP)__builtin_amdgcn_kernarg_segment_ptr(); asm volatile("" : "+s"(p)); return p; }
#define PH_ENTER const int tid = opq(threadIdx.x), lane = tid & 63, wave = __builtin_amdgcn_readfirstlane(tid >> 6); const int gw = vcu * 8 + wave; const int G = sopq(G0), ngw = G * 8; (void)ngw; \
    KP PP = kparams(); unsigned char* ws = PP->ws; unsigned char* mix = ws + WS_MIX; float* X = PP->out; (void)lane; (void)gw; (void)mix; (void)X; (void)tid;

__global__ void __launch_bounds__(512) mega_fwd(Params P_unused) {
    extern __shared__ __attribute__((aligned(16))) unsigned char lds_raw[];
    LAS unsigned char* lds = (LAS unsigned char*)lds_raw;
    cg::grid_group grid = cg::this_grid();
    const int G0 = gridDim.x, bx = blockIdx.x;
    const int vcu = (G0 % 8 == 0) ? (bx % 8) * (G0 / 8) + bx / 8 : bx;
    if (threadIdx.x < 2) ((volatile LAS unsigned*)(lds + LDS_MISC))[threadIdx.x] = 0u;
    __syncthreads();
    if (threadIdx.x == 0) (void)xb_add(&((unsigned*)(kparams()->ws + WS_BAR))[XB_XCNT(xb_xcc_id())], 1u);

    {
        PH_ENTER
        bf16_t* GU_T = (bf16_t*)(ws + WS_GU_T); bf16_t* D_T = (bf16_t*)(ws + WS_D_T); bf16_t* DQKV_T = (bf16_t*)(ws + WS_DQKV_T);
        bf16_t* UQ_T = (bf16_t*)(ws + WS_UQ_T); bf16_t* UK_T = (bf16_t*)(ws + WS_UK_T); bf16_t* UV_T = (bf16_t*)(ws + WS_UV_T);
        bf16_t* WO_T = (bf16_t*)(ws + WS_WO_T); bf16_t* FW_T = (bf16_t*)(ws + WS_FW_T);
        LAS float* scr = (LAS float*)(lds + wave * 8704);
        constexpr int NITEMS = 22528 + 11264 + 512 + 320 + 768 + 512 + 1024 + 1024;
        for (int rp = 0; rp < REP_PRO; ++rp) {
        for (int it = gw; it < NITEMS; it += ngw) {
            int r = it;
            if (r < 22528) { const int mtx = r / 1408, it2 = r % 1408, lf = mtx >> 1, gu = mtx & 1, kb = it2 / 88, n0 = (it2 % 88) * 32;
                transpose_item((gu ? PP->wu : PP->wg) + (size_t)lf * 1024 * DFF, DFF, GU_T + (size_t)lf * 5632 * 1024, 1024, (n0 >> 7) * 256 + gu * 128 + (n0 & 127), scr, kb * 64, n0, lane); continue; }
            r -= 22528;
            if (r < 11264) { const int mtx = r / 1408, it2 = r % 1408, kb = it2 / 32, n0 = (it2 % 32) * 32;
                transpose_item(PP->wd + (size_t)mtx * DFF * 1024, 1024, D_T + (size_t)mtx * 1024 * DFF, DFF, n0, scr, kb * 64, n0, lane); continue; }
            r -= 11264;
            if (r < 512) { const int j = r / 256, it2 = r % 256, kb = it2 / 16, n0 = (it2 % 16) * 32;
                transpose_item(PP->w_dq + (size_t)j * 1024 * 512, 512, DQKV_T + (size_t)j * 1024 * 1024, 1024, n0, scr, kb * 64, n0, lane); continue; }
            r -= 512;
            if (r < 320) { const int j = r / 160, it2 = r % 160, kb = it2 / 10, n0 = (it2 % 10) * 32;
                transpose_item(PP->w_dkv + (size_t)j * 1024 * 320, 320, DQKV_T + (size_t)j * 1024 * 1024, 1024, 512 + n0, scr, kb * 64, n0, lane); continue; }
            r -= 320;
            if (r < 768) { const int j = r / 384, it2 = r % 384, kb = it2 / 48, n0 = (it2 % 48) * 32;
                transpose_item(PP->w_uq + (size_t)j * 512 * 1536, 1536, UQ_T + (size_t)j * 1536 * 512, 512, n0, scr, kb * 64, n0, lane); continue; }
            r -= 768;
            if (r < 512) { const int j = r / 256, it2 = r % 256, kb = it2 / 64, n0 = (it2 % 64) * 32, hh = n0 >> 8, cc = n0 & 255;
                bf16_t* dst = (cc < 128 ? UK_T : UV_T) + (size_t)j * 1024 * 256;
                transpose_item(PP->w_ukv + (size_t)j * 256 * 2048, 2048, dst, 256, hh * 128 + (cc & 127), scr, kb * 64, n0, lane); continue; }
            r -= 512;
            if (r < 1024) { const int j = r / 512, it2 = r % 512, kb = it2 / 32, n0 = (it2 % 32) * 32;
                transpose_item(PP->w_o + (size_t)j * 1024 * 1024, 1024, WO_T + (size_t)j * 1024 * 1024, 1024, n0, scr, kb * 64, n0, lane); continue; }
            r -= 1024;
            { const int j = r / 512, it2 = r % 512, kb = it2 / 32, n0 = (it2 % 32) * 32;
                transpose_item(PP->fw + (size_t)j * 1024 * 1024, 1024, FW_T + (size_t)j * 1024 * 2048, 2048, n0, scr, kb * 64, n0, lane);
                transpose_item(PP->fw + (size_t)j * 1024 * 1024, 1024, FW_T + (size_t)j * 1024 * 2048 + 1024, 2048, n0, scr, kb * 64, n0, lane); }
        }
        float* PART = (float*)(mix + MX_MODPART);
        const float* c_ctx = PP->c_ctx; const float* cc = PP->c; const float* w_mod = PP->w_mod;
        for (int item = bx; item < 256; item += G) {
            const int l = item >> 6, kc = item & 63;
            f32x4 acc[3][5];
#pragma unroll
            for (int cnd = 0; cnd < 3; ++cnd)
#pragma unroll
                for (int jj = 0; jj < 5; ++jj) acc[cnd][jj] = (f32x4){0.f, 0.f, 0.f, 0.f};
            const bool has5 = tid < 256;
#pragma unroll 2
            for (int kk = 0; kk < 16; ++kk) {
                const int k = kc * 16 + kk;
                const float s0 = silu_f(c_ctx[k]), s1 = silu_f(cc[k]), s2 = silu_f(cc[1024 + k]);
                const float* wrow = w_mod + ((size_t)l * 1024 + k) * NMODC + 4 * tid;
#pragma unroll
                for (int jj = 0; jj < 5; ++jj) { if (jj < 4 || has5) { const f32x4 w = *(const f32x4*)(wrow + 2048 * jj); acc[0][jj] += w * s0; acc[1][jj] += w * s1; acc[2][jj] += w * s2; } }
            }
#pragma unroll
            for (int cnd = 0; cnd < 3; ++cnd)
#pragma unroll
                for (int jj = 0; jj < 5; ++jj) if (jj < 4 || has5) *(f32x4*)(PART + ((size_t)item * 3 + cnd) * NMODC + 4 * tid + 2048 * jj) = acc[cnd][jj];
        }
        }
        if (bx == G - 1) {
            float* ROPE = (float*)(ws + WS_ROPE); float* TAB = (float*)(ws + WS_TAB);
            for (int e = tid; e < 1024; e += 512) { const int idx = e >> 4, f = e & 15; double inv = 1.0; for (int q = 0; q < f; ++q) inv *= 0.56234132519034908;
                float cs, sn; sincos2pi((double)idx * inv * 0.15915494309189533577, cs, sn); ROPE[e] = cs; ROPE[1024 + e] = sn; }
            for (int e = tid; e < 4096; e += 512) { float cs, sn; sincos2pi((double)e * (1.0 / 4096.0), cs, sn); TAB[e] = cs; TAB[4096 + e] = sn; }
        }
    }
    grid.sync();
    {
        PH_ENTER
        const float* PART = (const float*)(mix + MX_MODPART); float* MOD = (float*)(ws + WS_MOD); const float* b_mod = PP->b_mod;
        for (int e = bx * 512 + tid; e < 4 * MODL; e += G * 512) {
            const int l = e / MODL, rem = e % MODL, n = rem % NMODC;
            float s = b_mod[l * NMODC + n];
#pragma unroll 8
            for (int kc = 0; kc < 64; ++kc) s += PART[(size_t)(l * 64 + kc) * MODL + rem];
            MOD[e] = s;
        }
        bf16_t* DSC = (bf16_t*)(ws + WS_DSC); bf16_t* DSS = (bf16_t*)(ws + WS_DSS); bf16_t* DC = (bf16_t*)(ws + WS_DC); bf16_t* CS = (bf16_t*)(ws + WS_CS); const float* TAB = (const float*)(ws + WS_TAB);
        for (int ch = bx * 512 + tid; ch < 4096 * (KFY / 8); ch += G * 512) {
            const int s = ch / (KFY / 8), c8 = ch % (KFY / 8); const bool sn = c8 >= KFC / 8; const int k0 = (sn ? c8 - KFC / 8 : c8) * 8;
            float v[8];
#pragma unroll
            for (int j = 0; j < 8; ++j) { const int k = k0 + j;
                if (!sn) v[j] = k <= 2048 ? TAB[(s * k) & 4095] * 0.015625f : 0.f;
                else v[j] = k <= 2046 ? -TAB[4096 + ((s * (k + 1)) & 4095)] * 0.015625f : 0.f; }
            u32x4 w; w.x = cvtpk(v[0], v[1]); w.y = cvtpk(v[2], v[3]); w.z = cvtpk(v[4], v[5]); w.w = cvtpk(v[6], v[7]);
            *(u32x4*)((sn ? DSS + (size_t)s * KFS : DSC + (size_t)s * KFC) + k0) = w;
        }
        for (int e = bx * 512 + tid; e < 256 * 512; e += G * 512) {
            const int s = e >> 9, k = e & 511; const bool sn = k >= 256; const int ix = ((s * (sn ? k - 256 : k)) & 255) * 16;
            DC[e] = f2bf(sn ? -TAB[4096 + ix] * 0.0625f : TAB[ix] * 0.0625f);
        }
        for (int e = bx * 512 + tid; e < 512 * 256; e += G * 512) {
            const int m = e >> 8, k = e & 255; const bool sn = m >= 256; const int ix = (((sn ? m - 256 : m) * k) & 255) * 16;
            CS[e] = f2bf(sn ? TAB[4096 + ix] * 0.0625f : TAB[ix] * 0.0625f);
        }
    }
    GRID_BAR();
    {
        PH_ENTER
        const float* MOD = (const float*)(ws + WS_MOD); const float* norm_g = PP->norm_g;
        float* GS = (float*)(ws + WS_GS);
        for (int e = bx * 512 + tid; e < 12 * 3 * 1024; e += G * 512) {
            const int p = e / 3072, rem = e % 3072, cnd = rem >> 10, col = rem & 1023, l = p / 3, sub = p % 3;
            GS[e] = norm_g[p * 1024 + col] * (1.0f + MOD[l * MODL + cnd * NMODC + (3 * sub + 1) * 1024 + col]);
        }
        for (int lf = 0; lf < 8; ++lf)
            shw_rows((const bf16_t*)(ws + WS_GU_T) + (size_t)lf * 5632 * 1024, 5632, MOD + (lf >> 1) * MODL + ((lf & 1) * 6) * 1024, (float*)(ws + WS_SHWGU) + (size_t)lf * 3 * 5632, 5632, gw, ngw, lane);
        for (int j = 0; j < 2; ++j)
            shw_rows((const bf16_t*)(ws + WS_DQKV_T) + (size_t)j * 1024 * 1024, 832, MOD + (2 * j) * MODL + 3 * 1024, (float*)(ws + WS_SHWDQ) + (size_t)j * 3 * 1024, 1024, gw, ngw, lane);
        { const bf16_t* CS = (const bf16_t*)(ws + WS_CS); float* SHC = (float*)(ws + WS_SHC);
          for (int e = bx * 512 + tid; e < 2 * 3 * 4 * 512; e += G * 512) {
              const int j = e / 6144, rem = e % 6144, cnd = rem / 2048, gq = (rem >> 9) & 3, m = rem & 511;
              const float* sh = MOD + (2 * j + 1) * MODL + cnd * NMODC + 3 * 1024 + gq * 256; const bf16_t* cr = CS + m * 256;
              float a = 0.f;
              for (int k = 0; k < 256; ++k) a += bf2f((short)cr[k]) * sh[k];
              SHC[e] = a;
          } }
        first_norm(PP->x_prompt, PP->x_sample, norm_g, MOD, (bf16_t*)(ws + WS_H), (float*)(ws + WS_SS), gw, ngw, lane);
    }
    GRID_BAR();

    for (int l = 0; l < 4; ++l) {
        for (int sub = 0; sub < 3; ++sub) {
#define XSRC const bool first = (l == 0 && sub == 0); const float* xlo = first ? PP->x_prompt : X; const float* xhi = first ? PP->x_sample : X + (size_t)NCTX * DM; \
             const float* modl = (const float*)(ws + WS_MOD) + l * MODL; const int jm = l >> 1; const int np = l * 3 + sub; const bool hn = np < 11; \
             const float* SSp = (const float*)(ws + WS_SS) + (size_t)np * NTOK * 4; float* SSn = (float*)(ws + WS_SS) + (size_t)(hn ? np + 1 : np) * NTOK * 4; const float* GSn = (const float*)(ws + WS_GS) + (size_t)(np + 1) * 3072; \
             bf16_t* Hn = (bf16_t*)(ws + WS_H); (void)jm; (void)modl; (void)xlo; (void)xhi; (void)SSp; (void)SSn; (void)GSn; (void)Hn;
            if (sub != 1) {
                {
                    PH_ENTER XSRC
                    const int lf = l * 2 + (sub >> 1);
                    pg8::Gemm g{(const bf16_t*)(ws + WS_H), (const bf16_t*)(ws + WS_GU_T) + (size_t)lf * 5632 * 1024, 1024, 1024, 1024, 64, 22, 1, 0, 0}; pg8::Order S; S.init(g, G, bx);
                    pg8::EpiSwiglu E{(bf16_t*)(mix + MX_ACT), SSp, (const float*)(ws + WS_SHWGU) + (size_t)lf * 3 * 5632}; for (int rp = 0; rp < REP_GU; ++rp) pg8::gemm_phase(lds, g, S, E);
                }
                GRID_BAR();
                {
                    PH_ENTER XSRC
                    const int lf = l * 2 + (sub >> 1);
                    pg8::Gemm g{(const bf16_t*)(mix + MX_ACT), (const bf16_t*)(ws + WS_D_T) + (size_t)lf * 1024 * DFF, DFF, DFF, DFF, 64, 4, 1, 0, 0}; pg8::Order S; S.init(g, G, bx);
                    pg8::EpiResid E{xlo, xhi, X, modl + (3 * sub + 2) * 1024, nullptr, Hn, GSn, SSn, lds, 0.5f, hn ? 1 : 0}; pg8::gemm_phase(lds, g, S, E);
                }
                GRID_BAR();
            } else {
                if ((l & 1) == 0) {
                    {
                        PH_ENTER XSRC
                        pg8::Gemm g{(const bf16_t*)(ws + WS_H), (const bf16_t*)(ws + WS_DQKV_T) + (size_t)jm * 1024 * 1024, 1024, 1024, 1024, 64, 4, 1, 0, 0}; pg8::Order S; S.init(g, G, bx);
                        pg8::EpiF32 E{(float*)(mix + MX_CQRAW), SSp, (const float*)(ws + WS_SHWDQ) + (size_t)jm * 3 * 1024}; pg8::gemm_phase(lds, g, S, E);
                    }
                    GRID_BAR();
                    {
                        PH_ENTER XSRC
                        const float* CQRAW = (const float*)(mix + MX_CQRAW); bf16_t* CQ = (bf16_t*)(mix + MX_CQ); bf16_t* CKV = (bf16_t*)(mix + MX_CKV); bf16_t* KPE = (bf16_t*)(mix + MX_KPE);
                        const float* ROPE = (const float*)(ws + WS_ROPE);
                        float* NEW_CKV = X + (size_t)NTOK * DM; float* NEW_KPE = NEW_CKV + (size_t)32 * 2 * 256 * 256;
                        const float* qn = PP->q_norm + jm * 512; const float* kn = PP->kv_norm + jm * 256;
                        const float* cache_ckv = PP->cache_ckv; const float* cache_kpe = PP->cache_kpe;
                        for (int kvrow = gw; kvrow < KVROWS; kvrow += ngw) {
                            int tok = -1, bb = 0, tt = 0, spos = 0; bool lat = false;
                            if (kvrow < NCTX) tok = kvrow;
                            else { const int rel = kvrow - NCTX; bb = rel / KVB; tt = rel % KVB; if (tt >= 512) { lat = true; spos = tt - 512; tok = NCTX + bb * 4096 + spos; } }
                            if (tok >= 0) {
                                const float* raw = CQRAW + (size_t)tok * 1024;
                                const f32x4 q0 = *(const f32x4*)(raw + 4 * lane), q1 = *(const f32x4*)(raw + 256 + 4 * lane), kv = *(const f32x4*)(raw + 512 + 4 * lane);
                                const float ssq = wave_sum((q0.x * q0.x + q0.y * q0.y) + (q0.z * q0.z + q0.w * q0.w) + (q1.x * q1.x + q1.y * q1.y) + (q1.z * q1.z + q1.w * q1.w), lane);
                                const float ssk = wave_sum((kv.x * kv.x + kv.y * kv.y) + (kv.z * kv.z + kv.w * kv.w), lane);
                                const float rq = 1.0f / sqrtf(ssq * (1.0f / 512.0f) + EPS), rk = 1.0f / sqrtf(ssk * (1.0f / 256.0f) + EPS);
                                const f32x4 y0 = q0 * rq * *(const f32x4*)(qn + 4 * lane), y1 = q1 * rq * *(const f32x4*)(qn + 256 + 4 * lane), yk = kv * rk * *(const f32x4*)(kn + 4 * lane);
                                u32x2 w; w.x = cvtpk(y0.x, y0.y); w.y = cvtpk(y0.z, y0.w); *(u32x2*)(CQ + (size_t)tok * 512 + 4 * lane) = w;
                                w.x = cvtpk(y1.x, y1.y); w.y = cvtpk(y1.z, y1.w); *(u32x2*)(CQ + (size_t)tok * 512 + 256 + 4 * lane) = w;
                                w.x = cvtpk(yk.x, yk.y); w.y = cvtpk(yk.z, yk.w); *(u32x2*)(CKV + (size_t)kvrow * 256 + 4 * lane) = w;
                                const size_t orow = (size_t)((tok >> 8) * 2 + jm) * 256 + (tok & 255);
                                if (!lat) *(f32x4*)(NEW_CKV + orow * 256 + 4 * lane) = yk;
                                if (lane < 32) {
                                    const int a = lane >> 4, f = lane & 15; const float x1 = raw[768 + a * 32 + f], x2 = raw[768 + a * 32 + 16 + f];
                                    float o1 = x1, o2 = x2;
                                    if (lat) { const int idx = a ? (spos & 63) : (spos >> 6); const float cr = ROPE[idx * 16 + f], sn = ROPE[1024 + idx * 16 + f]; o1 = x1 * cr - x2 * sn; o2 = x2 * cr + x1 * sn; }
                                    else { NEW_KPE[orow * 64 + a * 32 + f] = o1; NEW_KPE[orow * 64 + a * 32 + 16 + f] = o2; }
                                    KPE[(size_t)kvrow * 64 + a * 32 + f] = f2bf(o1); KPE[(size_t)kvrow * 64 + a * 32 + 16 + f] = f2bf(o2);
                                }
                            } else {
                                const size_t crow = (size_t)((bb * 2 + jm) * 512 + tt);
                                const f32x4 cv = *(const f32x4*)(cache_ckv + crow * 256 + 4 * lane);
                                u32x2 w; w.x = cvtpk(cv.x, cv.y); w.y = cvtpk(cv.z, cv.w); *(u32x2*)(CKV + (size_t)kvrow * 256 + 4 * lane) = w;
                                if (lane < 16) { const f32x4 pv = *(const f32x4*)(cache_kpe + crow * 64 + 4 * lane); w.x = cvtpk(pv.x, pv.y); w.y = cvtpk(pv.z, pv.w); *(u32x2*)(KPE + (size_t)kvrow * 64 + 4 * lane) = w; }
                            }
                        }
                    }
                    GRID_BAR();
                    for (int which = 0; which < 3; ++which) {
                        PH_ENTER
                        const int jm = l >> 1;
                        bf16_t* CQ = (bf16_t*)(mix + MX_CQ); bf16_t* CKV = (bf16_t*)(mix + MX_CKV);
                        pg8::Gemm g; pg8::EpiBf16 E; int rot;
                        if (which == 0) { g = pg8::Gemm{CQ, (const bf16_t*)(ws + WS_UQ_T) + (size_t)jm * 1536 * 512, 512, 512, 512, 64, 6, 1, 0, 0}; E = pg8::EpiBf16{(bf16_t*)(mix + MX_Q), 1536, 0, QSCALE}; rot = 0; }
                        else if (which == 1) { g = pg8::Gemm{CKV, (const bf16_t*)(ws + WS_UK_T) + (size_t)jm * 1024 * 256, 256, 256, 256, 68, 4, 1, 0, 0}; E = pg8::EpiBf16{(bf16_t*)(mix + MX_KN), 1024, 0, 1.0f}; rot = 384; }
                        else { g = pg8::Gemm{(const bf16_t*)(ws + WS_UV_T) + (size_t)jm * 1024 * 256, CKV, 256, 256, 256, 4, 68, 1, 0, 0}; E = pg8::EpiBf16{(bf16_t*)(mix + MX_VT), KVROWS, 0, 1.0f}; rot = 384 + 272; }
                        pg8::Order S; S.init(g, G, (bx + G - rot % G) % G);
                        pg8::gemm_phase(lds, g, S, E);
                    }
                    GRID_BAR();
                    {
                        PH_ENTER
                        AttnT T{(const bf16_t*)(mix + MX_Q), (const bf16_t*)(mix + MX_KN), (const bf16_t*)(mix + MX_KPE), (const bf16_t*)(mix + MX_VT), (bf16_t*)(mix + MX_O), (const float*)(ws + WS_ROPE)};
                        for (int rp = 0; rp < REP_ATTN; ++rp) {
                        for (int u = vcu; u < 256; u += G) { const int bh = u >> 4, qb = u & 15, b = bh >> 3, hh = bh & 7;
                            attn_unit(lds, T, NCTX + b * 4096 + qb * 256, hh, NCTX + b * KVB, KVB, qb * 256, true); }
                        for (int u = vcu; u < 256; u += G) { const int b = u >> 3, hh = u & 7;
                            attn_unit(lds, T, b * 256, hh, b * 256, 256, 0, false); }
                        }
                    }
                    GRID_BAR();
                } else {
                    {
                        PH_ENTER XSRC
                        {
                            const bf16_t* Hs = (const bf16_t*)(ws + WS_H); bf16_t* HFC = (bf16_t*)(mix + MX_HFC); bf16_t* HFS = (bf16_t*)(mix + MX_HFS);
                            for (int rr = gw; rr < 2 * (KFC + KFS); rr += ngw) {
                                const int b = rr / (KFC + KFS), q = rr % (KFC + KFS); const bool sn = q >= KFC; const int kq = sn ? q - KFC : q;
                                const int k = sn ? kq + 1 : kq;
                                const bool valid = sn ? (kq <= 2046) : (kq <= 2048); const bool two = (k >= 1 && k <= 2047);
                                bf16_t* dst = (sn ? HFS + ((size_t)b * KFS + kq) * 1024 : HFC + ((size_t)b * KFC + kq) * 1024) + 16 * lane;
                                u32x4 w0 = (u32x4){0u, 0u, 0u, 0u}, w1 = w0;
                                if (valid) {
                                    const int r1 = NCTX + b * 4096 + k, r2 = NCTX + b * 4096 + (two ? 4096 - k : k);
                                    const float rs1 = rsq_p4(SSp + (size_t)r1 * 4), rs2 = two ? rsq_p4(SSp + (size_t)r2 * 4) : 0.f;
                                    const float sg = sn ? -1.f : 1.f;
                                    const float* shp = modl + (1 + b) * NMODC + 3 * 1024 + 16 * lane;
                                    const bf16x8 a0 = *(const bf16x8*)(Hs + (size_t)r1 * 1024 + 16 * lane), a1 = *(const bf16x8*)(Hs + (size_t)r1 * 1024 + 16 * lane + 8);
                                    const bf16x8 c0 = *(const bf16x8*)(Hs + (size_t)r2 * 1024 + 16 * lane), c1 = *(const bf16x8*)(Hs + (size_t)r2 * 1024 + 16 * lane + 8);
                                    float v[16];
#pragma unroll
                                    for (int j = 0; j < 8; ++j) { v[j] = rs1 * bf2f(a0[j]) + sg * rs2 * bf2f(c0[j]); v[8 + j] = rs1 * bf2f(a1[j]) + sg * rs2 * bf2f(c1[j]); }
                                    if (!sn) { const float m2 = two ? 2.f : 1.f;
#pragma unroll
                                        for (int j = 0; j < 16; ++j) v[j] += m2 * shp[j]; }
                                    w0.x = cvtpk(v[0], v[1]); w0.y = cvtpk(v[2], v[3]); w0.z = cvtpk(v[4], v[5]); w0.w = cvtpk(v[6], v[7]);
                                    w1.x = cvtpk(v[8], v[9]); w1.y = cvtpk(v[10], v[11]); w1.z = cvtpk(v[12], v[13]); w1.w = cvtpk(v[14], v[15]);
                                }
                                *(u32x4*)dst = w0; *(u32x4*)(dst + 8) = w1;
                            }
                        }
                        pg8::Gemm g{(const bf16_t*)(ws + WS_CS), (const bf16_t*)(ws + WS_H), 256, 1024, 256, 2, 32, 4, 0, 256}; pg8::Order S; S.init(g, G, bx);
                        pg8::EpiYt E{(bf16_t*)(mix + MX_YTC), (bf16_t*)(mix + MX_YTC), SSp, (const float*)(ws + WS_SHC) + (size_t)jm * 3 * 4 * 512}; pg8::gemm_phase(lds, g, S, E);
                    }
                    GRID_BAR();
                    for (int which = 0; which < 2; ++which) {
                        PH_ENTER
                        bf16_t* YF = (bf16_t*)(mix + MX_YF);
                        pg8::Gemm g; pg8::EpiBf16 E; int rot;
                        if (which == 0) { g = pg8::Gemm{(const bf16_t*)(ws + WS_CS), (const bf16_t*)(mix + MX_HFC), 256, 1024, 256, 1, KFC / 256, 8, 0, (long)KFC * 1024, 2, 0, 256};
                            E = pg8::EpiBf16{YF, KFY, (long)1024 * KFY, 1.0f, 2, (long)256 * KFY}; rot = 0; }
                        else { g = pg8::Gemm{(const bf16_t*)(ws + WS_CS) + 256 * 256, (const bf16_t*)(mix + MX_HFS), 256, 1024, 256, 1, KFS / 256, 8, 0, (long)KFS * 1024, 2, 0, 256};
                            E = pg8::EpiBf16{YF + KFC, KFY, (long)1024 * KFY, 1.0f, 2, (long)256 * KFY}; rot = 8 * (KFC / 256); }
                        pg8::Order S; S.init(g, G, (bx + G - rot % G) % G);
                        pg8::gemm_phase(lds, g, S, E);
                    }
                    GRID_BAR();
                    for (int which = 0; which < 3; ++which) {
                        PH_ENTER
                        bf16_t* F = (bf16_t*)(mix + MX_F); const bf16_t* YF = (const bf16_t*)(mix + MX_YF);
                        pg8::Gemm g; pg8::EpiBf16 E; int rot;
                        if (which == 0) { g = pg8::Gemm{(const bf16_t*)(ws + WS_DSC), YF, KFC, KFY, KFC, 16, 4, 2, 0, (long)1024 * KFY};
                            E = pg8::EpiBf16{F + (size_t)NCTX * 2048, 2048, (long)4096 * 2048, 1.0f}; rot = 0; }
                        else if (which == 1) { g = pg8::Gemm{(const bf16_t*)(ws + WS_DSS), YF + KFC, KFS, KFY, KFS, 16, 4, 2, 0, (long)1024 * KFY};
                            E = pg8::EpiBf16{F + (size_t)NCTX * 2048 + 1024, 2048, (long)4096 * 2048, 1.0f}; rot = 128; }
                        else { g = pg8::Gemm{(const bf16_t*)(ws + WS_DC), (const bf16_t*)(mix + MX_YTC), 512, 512, 256, 1, 4, 64, 0, (long)1024 * 512, 1, 256, 256};
                            E = pg8::EpiBf16{F, 2048, (long)256 * 2048, 1.0f, 1, 1024}; rot = 0; }
                        pg8::Order S; S.init(g, G, (bx + G - rot % G) % G);
                        pg8::gemm_phase(lds, g, S, E);
                    }
                    GRID_BAR();
                }
                {
                    PH_ENTER XSRC
                    const bool mla = (l & 1) == 0;
                    const bf16_t* mixA = (const bf16_t*)(mix + (mla ? MX_O : MX_F));
                    const bf16_t* mixW = (const bf16_t*)(ws + (mla ? WS_WO_T : WS_FW_T)) + (size_t)jm * 1024 * (mla ? 1024 : 2048); const int mixK = mla ? 1024 : 2048;
                    const float* mixBias = mla ? nullptr : PP->fb + jm * 1024;
                    pg8::Gemm g{mixA, mixW, mixK, mixK, mixK, 64, 4, 1, 0, 0}; pg8::Order S; S.init(g, G, bx);
                    pg8::EpiResid E{xlo, xhi, X, modl + 5 * 1024, mixBias, Hn, GSn, SSn, lds, 1.0f, hn ? 1 : 0}; pg8::gemm_phase(lds, g, S, E);
                }
                GRID_BAR();
            }
        }
    }
    {
        PH_ENTER
        const float* fn = PP->final_norm;
        for (int row = gw; row < NTOK; row += ngw) {
            float* xr = X + (size_t)row * 1024 + 4 * lane;
            f32x4 v[4]; float ss = 0.f;
#pragma unroll
            for (int j = 0; j < 4; ++j) { v[j] = *(const f32x4*)(xr + 256 * j); ss += (v[j].x * v[j].x + v[j].y * v[j].y) + (v[j].z * v[j].z + v[j].w * v[j].w); }
            const float rs = 1.0f / sqrtf(wave_sum(ss, lane) * (1.0f / 1024.0f) + EPS);
#pragma unroll
            for (int j = 0; j < 4; ++j) *(f32x4*)(xr + 256 * j) = v[j] * rs * *(const f32x4*)(fn + 4 * lane + 256 * j);
        }
    }
}

extern "C" void kernel_launch(void* const* d_in, const int* in_sizes, int n_in, void* d_out, int out_size, void* d_ws, size_t ws_size, hipStream_t stream) {
    static int grid_blocks = 0;
    if (grid_blocks == 0) {
        if (n_in != 22 || ws_size < WS_END) { fprintf(stderr, "kernel_launch: need 22 inputs and >= %zu bytes of workspace (got %d, %zu)\n", (size_t)WS_END, n_in, ws_size); grid_blocks = -1; return; }
        int dev = 0, cus = 0, per_cu = 0;
        hipGetDevice(&dev);
        hipDeviceGetAttribute(&cus, hipDeviceAttributeMultiprocessorCount, dev);
        hipFuncSetAttribute((const void*)mega_fwd, hipFuncAttributeMaxDynamicSharedMemorySize, LDS_BYTES);
        hipOccupancyMaxActiveBlocksPerMultiprocessor(&per_cu, (const void*)mega_fwd, 512, LDS_BYTES);
        if (per_cu < 1) { fprintf(stderr, "kernel_launch: occupancy query says %d blocks per CU\n", per_cu); per_cu = 1; }
        (void)hipGetLastError();
        grid_blocks = cus;
    }
    if (grid_blocks < 0) return;
    (void)hipMemsetAsync((char*)d_ws + WS_BAR, 0, BAR_BYTES, stream);
    Params p{};
    const float** pp = (const float**)&p;
    for (int i = 0; i < 22; ++i) pp[i] = (const float*)d_in[i];
    p.out = (float*)d_out; p.ws = (unsigned char*)d_ws;
    void* args[] = {&p};
    hipError_t e = hipLaunchCooperativeKernel((const void*)mega_fwd, dim3(grid_blocks), dim3(512), args, LDS_BYTES, stream);
    if (e != hipSuccess) fprintf(stderr, "cooperative launch failed: %s (grid %d)\n", hipGetErrorString(e), grid_blocks);
}
```

```cpp
#include <hip/hip_runtime.h>
#include <hip/hip_cooperative_groups.h>
#include <cstdio>
#include <cstdint>
namespace cg = cooperative_groups;

#define LAS __attribute__((address_space(3)))
typedef unsigned short bf16_t;
typedef short bf16x8 __attribute__((ext_vector_type(8)));
typedef float f32x4 __attribute__((ext_vector_type(4)));
typedef float f32x2 __attribute__((ext_vector_type(2)));
typedef float f32x16 __attribute__((ext_vector_type(16)));
typedef unsigned u32x4 __attribute__((ext_vector_type(4)));
typedef unsigned u32x2 __attribute__((ext_vector_type(2)));
typedef __bf16 bf16x2_t __attribute__((ext_vector_type(2)));
#define DI __device__ __forceinline__

constexpr int DM = 1024, NTOK = 16384, NCTX = 8192, DFF = 2816, NMODC = 9216, MODL = 3 * NMODC;
constexpr int KVROWS = 17408;
constexpr int KVB = 4608;
constexpr float EPS = 1e-6f;
constexpr float QSCALE = 0.07216878364870323f * 1.4426950408889634f;

constexpr size_t al256(size_t x) { return (x + 255) & ~(size_t)255; }
constexpr size_t WS_BAR = 0, BAR_BYTES = 16384;
constexpr size_t WS_MOD = BAR_BYTES;
constexpr size_t WS_ROPE = al256(WS_MOD + (size_t)4 * MODL * 4);
constexpr size_t WS_TAB = al256(WS_ROPE + 2048 * 4);
constexpr size_t WS_GU_T = al256(WS_TAB + 8192 * 4);
constexpr size_t WS_D_T = al256(WS_GU_T + (size_t)8 * 5632 * 1024 * 2);
constexpr size_t WS_DQKV_T = al256(WS_D_T + (size_t)8 * 1024 * 2816 * 2);
constexpr size_t WS_UQ_T = al256(WS_DQKV_T + (size_t)2 * 1024 * 1024 * 2);
constexpr size_t WS_UK_T = al256(WS_UQ_T + (size_t)2 * 1536 * 512 * 2);
constexpr size_t WS_UV_T = al256(WS_UK_T + (size_t)2 * 1024 * 256 * 2);
constexpr size_t WS_WO_T = al256(WS_UV_T + (size_t)2 * 1024 * 256 * 2);
constexpr size_t WS_FW_T = al256(WS_WO_T + (size_t)2 * 1024 * 1024 * 2);
constexpr size_t WS_H = al256(WS_FW_T + (size_t)2 * 1024 * 2048 * 2);
constexpr size_t WS_SS = al256(WS_H + (size_t)NTOK * DM * 2);
constexpr size_t WS_GS = al256(WS_SS + (size_t)12 * NTOK * 4 * 4);
constexpr size_t WS_SHWGU = al256(WS_GS + (size_t)12 * 3 * 1024 * 4);
constexpr size_t WS_SHWDQ = al256(WS_SHWGU + (size_t)8 * 3 * 5632 * 4);
constexpr size_t WS_SHC = al256(WS_SHWDQ + (size_t)2 * 3 * 1024 * 4);
constexpr int KFC = 2304, KFS = 2048, KFY = KFC + KFS;
constexpr size_t WS_DSC = al256(WS_SHC + (size_t)2 * 3 * 4 * 512 * 4);
constexpr size_t WS_DSS = al256(WS_DSC + (size_t)4096 * KFC * 2);
constexpr size_t WS_DC = al256(WS_DSS + (size_t)4096 * KFS * 2);
constexpr size_t WS_CS = al256(WS_DC + (size_t)256 * 512 * 2);
constexpr size_t WS_MIX = al256(WS_CS + (size_t)512 * 256 * 2);
constexpr size_t MX_MODPART = 0;
constexpr size_t MX_ACT = 0;
constexpr size_t MX_SSQ = 0;
constexpr size_t MX_SSKV = al256(MX_SSQ + (size_t)NTOK * 2 * 4);
constexpr size_t MX_CQ = al256(MX_SSKV + (size_t)KVROWS * 4);
constexpr size_t MX_CKV = al256(MX_CQ + (size_t)NTOK * 512 * 2);
constexpr size_t MX_KPE = al256(MX_CKV + (size_t)KVROWS * 256 * 2);
constexpr size_t MX_Q = al256(MX_KPE + (size_t)KVROWS * 64 * 2);
constexpr size_t MX_KN = al256(MX_Q + (size_t)NTOK * 1536 * 2);
constexpr size_t MX_VT = al256(MX_KN + (size_t)KVROWS * 1024 * 2);
constexpr size_t MX_O = al256(MX_VT + (size_t)KVROWS * 1024 * 2);
constexpr size_t MX_MLA_END = al256(MX_O + (size_t)NTOK * 1024 * 2);
constexpr size_t MX_YF = 0;
constexpr size_t MX_HFC = al256(MX_YF + (size_t)2 * 1024 * KFY * 2);
constexpr size_t MX_HFS = al256(MX_HFC + (size_t)2 * KFC * 1024 * 2);
constexpr size_t MX_YTC = al256(MX_HFS + (size_t)2 * KFS * 1024 * 2);
constexpr size_t MX_F = al256(MX_YTC + (size_t)32 * 1024 * 512 * 2);
constexpr size_t MX_FOU_END = al256(MX_F + (size_t)NTOK * 2048 * 2);
constexpr size_t MX_SIZE = MX_MLA_END > MX_FOU_END ? MX_MLA_END : MX_FOU_END;
constexpr size_t WS_END = WS_MIX + MX_SIZE;
static_assert((size_t)NTOK * DFF * 2 <= MX_SIZE && (size_t)256 * MODL * 4 <= MX_SIZE, "mix region");

#ifndef ATT_SGB
#define ATT_SGB 1
#endif
#ifndef REP_ATTN
#define REP_ATTN 1
#endif
#ifndef REP_NORM
#define REP_NORM 1
#endif
#ifndef REP_PRO
#define REP_PRO 1
#endif
#ifndef REP_GU
#define REP_GU 1
#endif
constexpr int LDS_MISC = 147456;
constexpr int LDS_RED = LDS_MISC + 256;
constexpr int LDS_BYTES = LDS_MISC + 256 + 4096;

struct Params {
    const float *x_prompt, *x_sample, *cache_ckv, *cache_kpe, *c, *c_ctx, *w_mod, *b_mod, *norm_g, *wg, *wu, *wd,
        *w_dq, *q_norm, *w_uq, *w_dkv, *kv_norm, *w_ukv, *w_o, *fw, *fb, *final_norm;
    float* out; unsigned char* ws;
};

DI unsigned cvtpk(float lo, float hi) { f32x2 v = {lo, hi}; bf16x2_t b = __builtin_convertvector(v, bf16x2_t); return __builtin_bit_cast(unsigned, b); }
DI float bf2f(short v) { return __uint_as_float(((unsigned)(unsigned short)v) << 16); }
DI unsigned short f2bf(float f) { return (unsigned short)(cvtpk(f, 0.f) & 0xffffu); }
DI float shx(float v, int lane, int m) { return __int_as_float(__builtin_amdgcn_ds_bpermute((lane ^ m) << 2, __float_as_int(v))); }
DI float wave_sum(float v, int lane) {
#pragma unroll
    for (int o = 1; o < 64; o <<= 1) v += shx(v, lane, o);
    return v;
}
DI float max3f(float a, float b, float c) { float r; asm("v_max3_f32 %0, %1, %2, %3" : "=v"(r) : "v"(a), "v"(b), "v"(c)); return r; }
DI float fmax2f(float a, float b) { float r; asm("v_max_f32_e32 %0, %1, %2" : "=v"(r) : "v"(a), "v"(b)); return r; }
DI float rsq_p4(const float* p) { const f32x4 v = *(const f32x4*)p; return __builtin_amdgcn_rsqf(((v[0] + v[1]) + (v[2] + v[3])) * (1.0f / 1024.0f) + EPS); }
DI float rsq_ss(float ss) { return __builtin_amdgcn_rsqf(ss * (1.0f / 1024.0f) + EPS); }
DI float silu_f(float x) { return x * __builtin_amdgcn_rcpf(1.0f + __builtin_amdgcn_exp2f(-1.4426950408889634f * x)); }
DI int sopq(int v) { asm volatile("" : "+s"(v)); return v; }
DI int opq(int v) { asm volatile("" : "+v"(v)); return v; }
#define LDS_WAIT() asm volatile("s_waitcnt lgkmcnt(0)" ::: "memory")

namespace pg8 {
constexpr int BM = 256, BK = 64, HALF = 128, HTB = HALF * BK * 2, STAGE_BYTES = 8 * HTB, NXCD = 8, WGM = 8;
DI int lds_byte(int r, int c) { const int st = (r >> 4) * 2 + (c >> 5), rr = r & 15, cc = c & 31, ob = rr * 64 + cc * 2; return st * 1024 + (ob ^ (((ob >> 9) & 1) << 5)); }
DI void stage_rc(int b, int& R, int& C) { const int st = b / 1024, sb = b % 1024, swz = sb ^ (((sb >> 9) & 1) << 5); R = (st >> 1) * 16 + swz / 64; C = (st & 1) * 32 + (swz % 64) / 2; }
DI int perm32(int rho) { const int n = rho >> 4, i = rho & 15; return 8 * (i >> 2) + 4 * n + (i & 3); }

struct Unit { int z, pm, pn; };
struct Gemm { const bf16_t* A; const bf16_t* Bt; int lda, ldb, K, nM, nN, nZ; long sAz, sBz; int zsh = 0; long sAy = 0, sBy = 0; };

struct Order {
    int nM, nMz, nN, nwg, G, c;
    DI void init(const Gemm& g, int G_, int c_) { nM = g.nM; nMz = g.nM * g.nZ; nN = g.nN; nwg = nMz * nN; G = G_; c = c_; }
    DI bool next(int i, Unit& u) const {
        const long L = (long)i * G + c; if (L >= nwg) return false;
        int wgid = (int)L; { const int q = nwg / NXCD, r = nwg % NXCD, xcd = wgid % NXCD, off = wgid / NXCD; wgid = (xcd < r ? xcd * (q + 1) : r * (q + 1) + (xcd - r) * q) + off; }
        const int nig = WGM * nN, gid = wgid / nig, fm = gid * WGM, gsz = (nMz - fm) < WGM ? (nMz - fm) : WGM;
        const int pmz = fm + ((wgid % nig) % gsz); u.pn = (wgid % nig) / gsz; u.z = pmz / nM; u.pm = pmz % nM; return true;
    }
};

typedef f32x4 Acc[2][2][4][2];

struct EpiBf16 {
    static constexpr bool PERM = true, SPLIT = false;
    bf16_t* O; long ldc; long zs; float scale; int zsh = 0; long ys = 0; const float* rsrc = nullptr; int rmode = 0;
    DI void operator()(const Acc& acc, const Unit& u, int wr, int wc, int fr, int fq) const {
        bf16_t* base = O + (size_t)(u.z >> zsh) * zs + (size_t)(u.z & ((1 << zsh) - 1)) * ys + (size_t)(u.pm * BM + wr * 64 + fr) * ldc + u.pn * BM + wc * 32 + 8 * fq;
        f32x4 cs[2][2];
#pragma unroll
        for (int bj = 0; bj < 2; ++bj)
#pragma unroll
            for (int n = 0; n < 2; ++n) { cs[bj][n] = (f32x4){scale, scale, scale, scale};
                if (rmode == 3) { const f32x4 s = *(const f32x4*)(rsrc + u.pn * BM + bj * HALF + wc * 32 + 8 * fq + 4 * n);
#pragma unroll
                    for (int j = 0; j < 4; ++j) cs[bj][n][j] = scale * __builtin_amdgcn_rsqf(s[j] * (1.0f / 256.0f) + EPS); } }
#pragma unroll
        for (int ai = 0; ai < 2; ++ai)
#pragma unroll
            for (int m = 0; m < 4; ++m) { bf16_t* rowp = base + (size_t)(ai * HALF + m * 16) * ldc; float rf = 1.0f;
                const int row = u.pm * BM + ai * HALF + wr * 64 + m * 16 + fr;
                if (rmode == 1) { const f32x2 p = *(const f32x2*)(rsrc + (size_t)row * 2); rf = __builtin_amdgcn_rsqf((p[0] + p[1]) * (1.0f / 512.0f) + EPS); }
                if (rmode == 2) rf = __builtin_amdgcn_rsqf(rsrc[row] * (1.0f / 256.0f) + EPS);
#pragma unroll
                for (int bj = 0; bj < 2; ++bj) { const f32x4 v0 = acc[ai][bj][m][0] * cs[bj][0] * rf, v1 = acc[ai][bj][m][1] * cs[bj][1] * rf;
                    u32x4 w; w.x = cvtpk(v0[0], v0[1]); w.y = cvtpk(v0[2], v0[3]); w.z = cvtpk(v1[0], v1[1]); w.w = cvtpk(v1[2], v1[3]);
                    *(u32x4*)(rowp + bj * HALF) = w; } }
    }
};
struct EpiYt {
    static constexpr bool PERM = true;
    bf16_t* YtC; bf16_t* YtL; const float* SSp; const float* shc;
    DI void operator()(const Acc& acc, const Unit& u, int wr, int wc, int fr, int fq) const {
        bf16_t* tb; long ldc;
        if (u.pn < 32) { tb = YtC + (size_t)u.pn * 1024 * 512 + (size_t)(u.z * 256) * 512 + u.pm * 256; ldc = 512; }
        else { const int t = (u.pn - 32) * 256, b = t >> 12, s0 = t & 4095; tb = YtL + (size_t)b * 1024 * 8192 + (size_t)(u.z * 256) * 8192 + u.pm * 4096 + s0; ldc = 8192; }
        const int tok0 = u.pn * BM; const int cond = tok0 >= NCTX ? 1 + ((tok0 - NCTX) >> 12) : 0;
        const float* sc = shc + (cond * 4 + u.z) * 512 + u.pm * 256 + wr * 64 + fr;
        f32x4 rsv[2][2];
#pragma unroll
        for (int bj = 0; bj < 2; ++bj)
#pragma unroll
            for (int n = 0; n < 2; ++n) { const float* sp = SSp + (size_t)(tok0 + bj * HALF + wc * 32 + 8 * fq + 4 * n) * 4; rsv[bj][n] = (f32x4){rsq_p4(sp), rsq_p4(sp + 4), rsq_p4(sp + 8), rsq_p4(sp + 12)}; }
        bf16_t* base = tb + (size_t)(wr * 64 + fr) * ldc + wc * 32 + 8 * fq;
#pragma unroll
        for (int ai = 0; ai < 2; ++ai)
#pragma unroll
            for (int m = 0; m < 4; ++m) { bf16_t* rowp = base + (size_t)(ai * HALF + m * 16) * ldc; const float sh = sc[ai * HALF + m * 16];
#pragma unroll
                for (int bj = 0; bj < 2; ++bj) { const f32x4 v0 = acc[ai][bj][m][0] * rsv[bj][0] + sh, v1 = acc[ai][bj][m][1] * rsv[bj][1] + sh;
                    u32x4 w; w.x = cvtpk(v0[0], v0[1]); w.y = cvtpk(v0[2], v0[3]); w.z = cvtpk(v1[0], v1[1]); w.w = cvtpk(v1[2], v1[3]);
                    *(u32x4*)(rowp + bj * HALF) = w; } }
    }
};
struct EpiSwiglu {
    static constexpr bool PERM = true;
    bf16_t* O; const float* SSp; const float* shw;
    DI void operator()(const Acc& acc, const Unit& u, int wr, int wc, int fr, int fq) const {
        const int rowt = u.pm * BM; const int cond = rowt >= NCTX ? 1 + ((rowt - NCTX) >> 12) : 0;
        const float* sw = shw + cond * 5632 + u.pn * BM + wc * 32 + 8 * fq;
        const f32x4 sg0 = *(const f32x4*)sw, sg1 = *(const f32x4*)(sw + 4), su0 = *(const f32x4*)(sw + HALF), su1 = *(const f32x4*)(sw + HALF + 4);
        const float* ssr = SSp + (size_t)(rowt + wr * 64 + fr) * 4;
        bf16_t* base = O + (size_t)(u.pm * BM + wr * 64 + fr) * DFF + u.pn * HALF + wc * 32 + 8 * fq;
#pragma unroll
        for (int ai = 0; ai < 2; ++ai)
#pragma unroll
            for (int m = 0; m < 4; ++m) { bf16_t* rowp = base + (size_t)(ai * HALF + m * 16) * DFF; const float rs = rsq_p4(ssr + (ai * HALF + m * 16) * 4);
                const f32x4 g0 = acc[ai][0][m][0] * rs + sg0, g1 = acc[ai][0][m][1] * rs + sg1, u0 = acc[ai][1][m][0] * rs + su0, u1 = acc[ai][1][m][1] * rs + su1;
                float v[8];
#pragma unroll
                for (int j = 0; j < 4; ++j) { v[j] = silu_f(g0[j]) * u0[j]; v[4 + j] = silu_f(g1[j]) * u1[j]; }
                u32x4 w; w.x = cvtpk(v[0], v[1]); w.y = cvtpk(v[2], v[3]); w.z = cvtpk(v[4], v[5]); w.w = cvtpk(v[6], v[7]);
                *(u32x4*)rowp = w; }
    }
};
struct EpiDq {
    static constexpr bool PERM = false, SPLIT = false;
    bf16_t* CQ; bf16_t* CKV; bf16_t* KPE; float* NCKV; float* NKPE; float* SSQ; float* SSKV; const float* SSp; const float* shw; const float* qn; const float* kn; const float* rope; LAS unsigned char* lds; int jm;
    DI void operator()(const Acc& acc, const Unit& u, int wr, int wc, int fr_, int fq_) const {
        const int fr = opq(fr_), fq = opq(fq_);
        const int rowt = u.pm * BM; const bool hi = rowt >= NCTX; const int cond = hi ? 1 + ((rowt - NCTX) >> 12) : 0;
        int kv0, s0 = 0, orow0 = 0;
        if (!hi) { kv0 = rowt; orow0 = ((rowt >> 8) * 2 + jm) * 256; }
        else { const int rel = rowt - NCTX, b = rel >> 12; s0 = rel & 4095; kv0 = NCTX + b * KVB + 512 + s0; }
        const float* sw = shw + cond * 1024 + u.pn * BM + wc * 32 + 4 * fq;
        const float* ssr = SSp + (size_t)(rowt + wr * 64 + fr) * 4;
        LAS float* red = (LAS float*)(lds + LDS_RED);
        const int pn = u.pn, ln = fq * 16 + fr;
#pragma unroll
        for (int ai = 0; ai < 2; ++ai)
#pragma unroll
            for (int m = 0; m < 4; ++m) { const int rl = ai * HALF + wr * 64 + m * 16 + fr; const float rs = rsq_p4(ssr + (ai * HALF + m * 16) * 4); float sq = 0.f;
                f32x4 v[2][2];
#pragma unroll
                for (int bj = 0; bj < 2; ++bj)
#pragma unroll
                    for (int n = 0; n < 2; ++n) { v[bj][n] = acc[ai][bj][m][n] * rs + *(const f32x4*)(sw + bj * HALF + n * 16);
                        sq += (v[bj][n][0] * v[bj][n][0] + v[bj][n][1] * v[bj][n][1]) + (v[bj][n][2] * v[bj][n][2] + v[bj][n][3] * v[bj][n][3]); }
                if (pn < 2) {
#pragma unroll
                    for (int bj = 0; bj < 2; ++bj)
#pragma unroll
                        for (int n = 0; n < 2; ++n) { const int c = pn * BM + bj * HALF + wc * 32 + 16 * n + 4 * fq; const f32x4 w4 = v[bj][n] * *(const f32x4*)(qn + c);
                            u32x2 w; w.x = cvtpk(w4[0], w4[1]); w.y = cvtpk(w4[2], w4[3]); *(u32x2*)(CQ + (size_t)(rowt + rl) * 512 + c) = w; }
                } else if (pn == 2) {
#pragma unroll
                    for (int bj = 0; bj < 2; ++bj)
#pragma unroll
                        for (int n = 0; n < 2; ++n) { const int c = bj * HALF + wc * 32 + 16 * n + 4 * fq; const f32x4 w4 = v[bj][n] * *(const f32x4*)(kn + c);
                            u32x2 w; w.x = cvtpk(w4[0], w4[1]); w.y = cvtpk(w4[2], w4[3]); *(u32x2*)(CKV + (size_t)(kv0 + rl) * 256 + c) = w;
                            if (!hi) *(f32x4*)(NCKV + (size_t)(orow0 + rl) * 256 + c) = w4; }
                } else if (wc < 2) {
                    f32x4 o1 = v[0][0], o2 = v[0][1];
                    if (hi) { const int pos = s0 + rl, idx = wc ? (pos & 63) : (pos >> 6);
                        const f32x4 c4 = *(const f32x4*)(rope + idx * 16 + 4 * fq), s4 = *(const f32x4*)(rope + 1024 + idx * 16 + 4 * fq);
                        o1 = v[0][0] * c4 - v[0][1] * s4; o2 = v[0][1] * c4 + v[0][0] * s4; }
                    else { *(f32x4*)(NKPE + (size_t)(orow0 + rl) * 64 + wc * 32 + 4 * fq) = o1; *(f32x4*)(NKPE + (size_t)(orow0 + rl) * 64 + wc * 32 + 16 + 4 * fq) = o2; }
                    u32x2 w; w.x = cvtpk(o1[0], o1[1]); w.y = cvtpk(o1[2], o1[3]); *(u32x2*)(KPE + (size_t)(kv0 + rl) * 64 + wc * 32 + 4 * fq) = w;
                    w.x = cvtpk(o2[0], o2[1]); w.y = cvtpk(o2[2], o2[3]); *(u32x2*)(KPE + (size_t)(kv0 + rl) * 64 + wc * 32 + 16 + 4 * fq) = w;
                }
                if (pn < 3) { sq += shx(sq, ln, 16); sq += shx(sq, ln, 32); if (fq == 0) red[rl * 4 + wc] = sq; } }
        if (pn < 3) {
            asm volatile("s_waitcnt lgkmcnt(0)" ::: "memory"); __builtin_amdgcn_s_barrier(); asm volatile("" ::: "memory");
            const int t = wr * 256 + wc * 64 + fq * 16 + fr;
            if (t < 256) { const f32x4 p = *(const LAS f32x4*)(red + t * 4); const float s = (p[0] + p[1]) + (p[2] + p[3]);
                if (pn < 2) SSQ[(size_t)(rowt + t) * 2 + pn] = s; else SSKV[kv0 + t] = s; }
        }
    }
};
struct EpiResid {
    static constexpr bool PERM = true;
    const float* xlo; const float* xhi; float* out; const float* coef; const float* bias; bf16_t* Hs; const float* gsn; float* ssn; LAS unsigned char* lds; float cmul; int wh_;
    DI void operator()(Acc& acc, const Unit& u, int wr, int wc, int fr, int fq) const {
        const int rowt = u.pm * BM; const bool hi = rowt >= NCTX;
        const int cond = hi ? 1 + ((rowt - NCTX) >> 12) : 0;
        const float* cf = coef + cond * NMODC;
        const float* xb = hi ? xhi + (size_t)(rowt - NCTX) * 1024 : xlo + (size_t)rowt * 1024;
        float* ob = out + (size_t)rowt * 1024;
        const int col0 = u.pn * BM + wc * 32 + 8 * fq;
        const bool wh = wh_ != 0;
        LAS float* red = (LAS float*)(lds + LDS_RED);
        if (bias) {
#pragma unroll
            for (int bj = 0; bj < 2; ++bj)
#pragma unroll
                for (int n = 0; n < 2; ++n) { const f32x4 b4 = *(const f32x4*)(bias + col0 + bj * HALF + n * 4);
#pragma unroll
                    for (int ai = 0; ai < 2; ++ai)
#pragma unroll
                        for (int m = 0; m < 4; ++m) acc[ai][bj][m][n] += b4; }
        }
        f32x4 cv[2][2], gv[2][2];
#pragma unroll
        for (int bj = 0; bj < 2; ++bj)
#pragma unroll
            for (int n = 0; n < 2; ++n) { const int cc = col0 + bj * HALF + n * 4; cv[bj][n] = *(const f32x4*)(cf + cc) * cmul;
                gv[bj][n] = wh ? *(const f32x4*)(gsn + cond * 1024 + cc) : (f32x4){0.f, 0.f, 0.f, 0.f}; }
#pragma unroll
        for (int ai = 0; ai < 2; ++ai)
#pragma unroll
            for (int m = 0; m < 4; ++m) { const int rl = ai * HALF + wr * 64 + m * 16 + fr; const size_t roff = (size_t)rl * 1024 + col0; float sq = 0.f;
#pragma unroll
                for (int bj = 0; bj < 2; ++bj) { const size_t off = roff + bj * HALF;
                    const f32x4 x0 = *(const f32x4*)(xb + off), x1 = *(const f32x4*)(xb + off + 4);
                    const f32x4 o0 = x0 + cv[bj][0] * acc[ai][bj][m][0], o1 = x1 + cv[bj][1] * acc[ai][bj][m][1];
                    *(f32x4*)(ob + off) = o0; *(f32x4*)(ob + off + 4) = o1;
                    if (wh) { sq += ((o0[0] * o0[0] + o0[1] * o0[1]) + (o0[2] * o0[2] + o0[3] * o0[3])) + ((o1[0] * o1[0] + o1[1] * o1[1]) + (o1[2] * o1[2] + o1[3] * o1[3]));
                        const f32x4 h0 = o0 * gv[bj][0], h1 = o1 * gv[bj][1];
                        u32x4 w; w.x = cvtpk(h0[0], h0[1]); w.y = cvtpk(h0[2], h0[3]); w.z = cvtpk(h1[0], h1[1]); w.w = cvtpk(h1[2], h1[3]);
                        *(u32x4*)(Hs + (size_t)rowt * 1024 + off) = w; } }
                if (wh) { const int ln = fq * 16 + fr; sq += shx(sq, ln, 16); sq += shx(sq, ln, 32); if (fq == 0) red[rl * 4 + wc] = sq; } }
        if (wh) {
            asm volatile("s_waitcnt lgkmcnt(0)" ::: "memory"); __builtin_amdgcn_s_barrier(); asm volatile("" ::: "memory");
            const int t = wr * 256 + wc * 64 + fq * 16 + fr;
            if (t < 256) { const f32x4 p = *(const LAS f32x4*)(red + t * 4); ssn[(size_t)(rowt + t) * 4 + u.pn] = (p[0] + p[1]) + (p[2] + p[3]); }
        }
    }
};

template <class Epi>
DI void gemm_phase(LAS unsigned char* lds, const Gemm g, const Order& S, const Epi& E) {
    const int tid = opq(threadIdx.x), wid = __builtin_amdgcn_readfirstlane(tid >> 6), lane = tid & 63, wr = wid >> 2, wc = wid & 3, fr = lane & 15, fq = lane >> 4;
    const int K = g.K, nt = K / BK;
    unsigned voffA[2], voffB[2];
#pragma unroll
    for (int i = 0; i < 2; ++i) { int R, C; stage_rc(tid * 16 + i * 8192, R, C); const int Rb = Epi::PERM ? ((R & ~31) + perm32(R & 31)) : R;
        voffA[i] = (unsigned)(R * g.lda + C) * 2u; voffB[i] = (unsigned)(Rb * g.ldb + C) * 2u; }
    const size_t kstep = (size_t)(BK * 2);
    const size_t hstepA = (size_t)HALF * g.lda * 2, hstepB = (size_t)HALF * g.ldb * 2;
    const unsigned ldsw = (unsigned)wid * 1024u;
    const int aoff = lds_byte(wr * 64 + fr, fq * 8), boff = lds_byte(wc * 32 + fr, fq * 8);
#define PG8_UA(u) ((const char*)g.A + ((size_t)((u).z >> g.zsh) * g.sAz + (size_t)((u).z & ((1 << g.zsh) - 1)) * g.sAy + (size_t)(u).pm * BM * g.lda) * 2)
#define PG8_UB(u) ((const char*)g.Bt + ((size_t)((u).z >> g.zsh) * g.sBz + (size_t)((u).z & ((1 << g.zsh) - 1)) * g.sBy + (size_t)(u).pn * BM * g.ldb) * 2)
#define PG8_SA(b, h) (((b) * 2 + (h)) * HTB)
#define PG8_SB(b, h) ((4 + (b) * 2 + (h)) * HTB)
#define PG8_STAGE(bufoff, gbase, voff) do { _Pragma("unroll") for (int _i = 0; _i < 2; ++_i) \
        __builtin_amdgcn_global_load_lds((const unsigned*)((const char*)(gbase) + (voff)[_i]), (LAS unsigned*)(lds + (bufoff) + ldsw + _i * 8192), 16, 0, 0); } while (0)
#define PG8_LDA(dst, b, h) do { _Pragma("unroll") for (int m = 0; m < 4; ++m) _Pragma("unroll") for (int k = 0; k < 2; ++k) dst[m][k] = *(const LAS bf16x8*)(lds + PG8_SA(b, h) + aoff + m * 2048 + k * 1024); } while (0)
#define PG8_LDB(dst, b, h) do { _Pragma("unroll") for (int n = 0; n < 2; ++n) _Pragma("unroll") for (int k = 0; k < 2; ++k) dst[n][k] = *(const LAS bf16x8*)(lds + PG8_SB(b, h) + boff + n * 2048 + k * 1024); } while (0)
#define PG8_MMA(ai, bj, At, Bt) do { __builtin_amdgcn_s_setprio(1); _Pragma("unroll") for (int m = 0; m < 4; ++m) _Pragma("unroll") for (int n = 0; n < 2; ++n) _Pragma("unroll") for (int k = 0; k < 2; ++k) \
        acc[ai][bj][m][n] = __builtin_amdgcn_mfma_f32_16x16x32_bf16(Bt[n][k], At[m][k], acc[ai][bj][m][n], 0, 0, 0); __builtin_amdgcn_s_setprio(0); } while (0)
#define PG8_WAIT_V(n) asm volatile("s_waitcnt vmcnt(" #n ")" ::: "memory")
#define PG8_WAIT_L(n) asm volatile("s_waitcnt lgkmcnt(" #n ")" ::: "memory")
#define PG8_BAR __builtin_amdgcn_s_barrier()
#define PG8_SCHED __builtin_amdgcn_sched_barrier(0)
    Unit cur, nxt; int ui = 0;
    if (!S.next(0, cur)) return;
    Acc acc;
#pragma unroll
    for (int a = 0; a < 2; ++a)
#pragma unroll
        for (int b = 0; b < 2; ++b)
#pragma unroll
            for (int m = 0; m < 4; ++m)
#pragma unroll
                for (int n = 0; n < 2; ++n) acc[a][b][m][n] = (f32x4){0.f, 0.f, 0.f, 0.f};
    bf16x8 At[4][2], B0[2][2], B1[2][2];
    const char* cA = PG8_UA(cur); const char* cB = PG8_UB(cur);
    PG8_STAGE(PG8_SB(0, 0), cB, voffB); PG8_STAGE(PG8_SB(0, 1), cB + hstepB, voffB); PG8_STAGE(PG8_SA(0, 0), cA, voffA); PG8_STAGE(PG8_SA(0, 1), cA + hstepA, voffA);
    if (wr == 1) PG8_BAR;
    PG8_WAIT_V(2); PG8_BAR;
    PG8_STAGE(PG8_SB(1, 0), cB + kstep, voffB); PG8_STAGE(PG8_SA(1, 0), cA + kstep, voffA); PG8_STAGE(PG8_SB(1, 1), cB + hstepB + kstep, voffB);
    PG8_WAIT_V(6); PG8_BAR;
    for (;;) {
        const bool has_next = S.next(ui + 1, nxt);
        const char* nA = has_next ? PG8_UA(nxt) : cA; const char* nB = has_next ? PG8_UB(nxt) : cB;
        for (int t = 0; t < nt; t += 2) {
            const bool last = (t == nt - 2);
            const char* a1 = cA + (size_t)(t + 1) * kstep;
            const char* a2 = last ? nA : cA + (size_t)(t + 2) * kstep; const char* b2 = last ? nB : cB + (size_t)(t + 2) * kstep;
            const char* a3 = a2 + kstep; const char* b3 = b2 + kstep;
            PG8_LDB(B0, 0, 0); PG8_LDB(B1, 0, 1); PG8_SCHED; PG8_LDA(At, 0, 0); PG8_STAGE(PG8_SA(1, 1), a1 + hstepA, voffA);
            PG8_WAIT_V(8); PG8_WAIT_L(0); PG8_BAR; PG8_MMA(0, 0, At, B0); PG8_MMA(0, 1, At, B1); PG8_BAR; PG8_SCHED;
            PG8_LDA(At, 0, 1); PG8_STAGE(PG8_SB(0, 0), b2, voffB); PG8_STAGE(PG8_SB(0, 1), b2 + hstepB, voffB); PG8_STAGE(PG8_SA(0, 0), a2, voffA);
            PG8_WAIT_V(8); PG8_WAIT_L(0); PG8_BAR; PG8_MMA(1, 0, At, B0); PG8_MMA(1, 1, At, B1); PG8_BAR; PG8_SCHED;
            PG8_LDB(B0, 1, 0); PG8_LDB(B1, 1, 1); PG8_SCHED; PG8_LDA(At, 1, 0); PG8_STAGE(PG8_SA(0, 1), a2 + hstepA, voffA);
            PG8_WAIT_V(8); PG8_WAIT_L(0); PG8_BAR; PG8_MMA(0, 0, At, B0); PG8_MMA(0, 1, At, B1); PG8_BAR; PG8_SCHED;
            PG8_LDA(At, 1, 1); PG8_STAGE(PG8_SB(1, 0), b3, voffB); PG8_STAGE(PG8_SB(1, 1), b3 + hstepB, voffB); PG8_STAGE(PG8_SA(1, 0), a3, voffA);
            PG8_WAIT_V(8); PG8_WAIT_L(0); PG8_BAR; PG8_MMA(1, 0, At, B0); PG8_MMA(1, 1, At, B1); PG8_BAR; PG8_SCHED;
        }
        if (wr == 0) PG8_BAR;
        E(acc, cur, wr, wc, fr, fq);
        if (!has_next) break;
#pragma unroll
        for (int a = 0; a < 2; ++a)
#pragma unroll
            for (int b = 0; b < 2; ++b)
#pragma unroll
                for (int m = 0; m < 4; ++m)
#pragma unroll
                    for (int n = 0; n < 2; ++n) acc[a][b][m][n] = (f32x4){0.f, 0.f, 0.f, 0.f};
        cur = nxt; cA = nA; cB = nB; ++ui;
        if (wr == 1) PG8_BAR;
    }
    PG8_WAIT_V(0);
    PG8_BAR;
#undef PG8_UA
#undef PG8_UB
#undef PG8_SA
#undef PG8_SB
#undef PG8_STAGE
#undef PG8_LDA
#undef PG8_LDB
#undef PG8_MMA
#undef PG8_WAIT_V
#undef PG8_WAIT_L
#undef PG8_BAR
#undef PG8_SCHED
}
}

struct AttnT { const bf16_t* Q; const bf16_t* KN; const bf16_t* KPE; const bf16_t* VT; bf16_t* O; const float* rope; };
constexpr int AK_ROW = 384, AK_BUF = 64 * AK_ROW, AV_ROW = 128, AV_BUF = 128 * AV_ROW, AV_OFF = 4 * AK_BUF;
static_assert(AV_OFF + 3 * AV_BUF <= LDS_MISC, "attention LDS");

DI void attn_unit(LAS unsigned char* lds, const AttnT& T, int qrow0, int h, int kv0, int nk, int pos0, bool rope) {
    const int tid = opq(threadIdx.x), lane = tid & 63, wid = tid >> 6, r = lane & 31, h2 = lane >> 5;
    const int pr = (r & ~12) | ((r & 4) << 1) | ((r & 8) >> 1);
    bf16x8 qf[12];
    { const bf16_t* qp = T.Q + (size_t)(qrow0 + 32 * wid + r) * 1536 + h * 192 + 8 * h2;
#pragma unroll
      for (int ks = 0; ks < 12; ++ks) qf[ks] = *(const bf16x8*)(qp + 16 * ks); }
    if (rope) {
        const int pos = pos0 + 32 * wid + r;
#pragma unroll
        for (int a = 0; a < 2; ++a) {
            const int idx = a ? (pos & 63) : (pos >> 6);
            const float* cs = T.rope + idx * 16 + 8 * h2;
            const f32x4 c0 = *(const f32x4*)cs, c1 = *(const f32x4*)(cs + 4), s0 = *(const f32x4*)(cs + 1024), s1 = *(const f32x4*)(cs + 1028);
            bf16x8 x1 = qf[8 + 2 * a], x2 = qf[9 + 2 * a], o1, o2;
#pragma unroll
            for (int j = 0; j < 8; ++j) { const float cc = j < 4 ? c0[j & 3] : c1[j & 3], sn = j < 4 ? s0[j & 3] : s1[j & 3];
                const float a1 = bf2f(x1[j]), a2 = bf2f(x2[j]);
                o1[j] = (short)f2bf(a1 * cc - a2 * sn); o2[j] = (short)f2bf(a2 * cc + a1 * sn); }
            qf[8 + 2 * a] = o1; qf[9 + 2 * a] = o2;
        }
    }
    const char* gk[3]; unsigned skb[3];
#pragma unroll
    for (int j = 0; j < 3; ++j) { const int c = (wid * 3 + j) * 64 + lane, row = c / 24, pc = c - row * 24, lc = pc ^ ((row >> 1) & 7);
        const bool nope = lc < 16;
        gk[j] = nope ? (const char*)(T.KN + (size_t)(kv0 + row) * 1024 + h * 128 + lc * 8) : (const char*)(T.KPE + (size_t)(kv0 + row) * 64 + (lc - 16) * 8);
        skb[j] = nope ? 64u * 1024u * 2u : 64u * 64u * 2u; }
    const char* gv[2];
#pragma unroll
    for (int j = 0; j < 2; ++j) { const int c = (wid * 2 + j) * 64 + lane, row = c >> 3, lc = (c & 7) ^ ((row >> 1) & 7);
        gv[j] = (const char*)(T.VT + (size_t)(h * 128 + row) * KVROWS + kv0 + lc * 8); }
    const int wid_u = __builtin_amdgcn_readfirstlane(wid);
#define ATT_DMA_K(t, slot) do { _Pragma("unroll") for (int j_ = 0; j_ < 3; ++j_) \
        __builtin_amdgcn_global_load_lds((const unsigned*)(gk[j_] + (size_t)(t) * skb[j_]), (LAS unsigned*)(lds + (slot) * AK_BUF + (wid_u * 3 + j_) * 1024), 16, 0, 0); } while (0)
#define ATT_DMA_V(t, slot) do { _Pragma("unroll") for (int j_ = 0; j_ < 2; ++j_) \
        __builtin_amdgcn_global_load_lds((const unsigned*)(gv[j_] + (size_t)(t) * 128), (LAS unsigned*)(lds + AV_OFF + (slot) * AV_BUF + (wid_u * 2 + j_) * 1024), 16, 0, 0); } while (0)
#define ATT_WAIT_V(n) asm volatile("s_waitcnt vmcnt(" #n ")" ::: "memory")
#define ATT_BAR() do { __builtin_amdgcn_s_barrier(); asm volatile("" ::: "memory"); } while (0)
    const int kswz = (pr >> 1) & 7, vswz = (r >> 1) & 7;
    int kco[4], vco[4];
#pragma unroll
    for (int j = 0; j < 4; ++j) { kco[j] = pr * AK_ROW + (((2 * j + h2) ^ kswz) << 4); vco[j] = AV_OFF + r * AV_ROW + (((2 * j + h2) ^ vswz) << 4); }
#define ATT_KF(slotbase, kb2, ks) (*(const LAS bf16x8*)((slotbase) + (kb2) * 32 * AK_ROW + kco[(ks) & 3] + ((ks) >> 2) * 128))
    f32x16 o[4];
#pragma unroll
    for (int d = 0; d < 4; ++d)
#pragma unroll
        for (int i = 0; i < 16; ++i) o[d][i] = 0.f;
    float mrun = -1e30f, lrun = 0.f;
    const int ntile = nk >> 6, tlast = ntile - 1;
    ATT_DMA_K(0, 0); ATT_DMA_V(0, 0); ATT_DMA_K(1 < tlast ? 1 : tlast, 1);
    ATT_DMA_K(2 < tlast ? 2 : tlast, 2); ATT_DMA_V(1 < tlast ? 1 : tlast, 1);
    ATT_WAIT_V(5); ATT_BAR();
    f32x16 s0, s1;
#pragma unroll
    for (int i = 0; i < 16; ++i) { s0[i] = 0.f; s1[i] = 0.f; }
    { const LAS unsigned char* kb_ = lds;
#pragma unroll
      for (int ks = 0; ks < 12; ++ks) { const bf16x8 k0_ = ATT_KF(kb_, 0, ks), k1_ = ATT_KF(kb_, 1, ks);
          s0 = __builtin_amdgcn_mfma_f32_32x32x16_bf16(k0_, qf[ks], s0, 0, 0, 0); s1 = __builtin_amdgcn_mfma_f32_32x32x16_bf16(k1_, qf[ks], s1, 0, 0, 0); } }
    int ksl = 1, vsl = 0;
    for (int t = 0; t < ntile; ++t) {
        { const int tk = t + 3 < tlast ? t + 3 : tlast, tv = t + 2 < tlast ? t + 2 : tlast;
          const int kd = (ksl + 2) & 3, vd = vsl + 2 >= 3 ? vsl - 1 : vsl + 2; ATT_DMA_K(tk, kd); ATT_DMA_V(tv, vd); }
        f32x16 n0, n1;
#pragma unroll
        for (int i = 0; i < 16; ++i) { n0[i] = 0.f; n1[i] = 0.f; }
        const LAS unsigned char* kb_ = lds + ksl * AK_BUF;
        bf16x8 ka0 = ATT_KF(kb_, 0, 0), ka1 = ATT_KF(kb_, 1, 0), kn0 = ATT_KF(kb_, 0, 1), kn1 = ATT_KF(kb_, 1, 1);
        float mx = 0.f, oth = 0.f, mnew = 0.f, alpha = 1.f, ps = 0.f;
#define SEL(e) ((e) < 16 ? s0[(e) & 15] : s1[(e) & 15])
#define PEXP(e) do { const float p_ = __builtin_amdgcn_exp2f(SEL(e) - mnew); if ((e) < 16) s0[(e) & 15] = p_; else s1[(e) & 15] = p_; ps += p_; } while (0)
#pragma unroll
        for (int ks = 0; ks < 12; ++ks) {
            bf16x8 kf0 = kn0, kf1 = kn1;
            if (ks < 10) { kf0 = ATT_KF(kb_, 0, ks + 2); kf1 = ATT_KF(kb_, 1, ks + 2); }
            n0 = __builtin_amdgcn_mfma_f32_32x32x16_bf16(ka0, qf[ks], n0, 0, 0, 0);
            n1 = __builtin_amdgcn_mfma_f32_32x32x16_bf16(ka1, qf[ks], n1, 0, 0, 0);
            if (ks == 0) { mx = max3f(s0[0], s0[1], s0[2]);
#pragma unroll
                for (int i = 3; i < 15; i += 2) mx = max3f(mx, s0[i], s0[i + 1]);
                mx = max3f(mx, s0[15], s1[0]); }
            if (ks == 1) {
#pragma unroll
                for (int i = 1; i < 15; i += 2) mx = max3f(mx, s1[i], s1[i + 1]);
                mx = fmax2f(mx, s1[15]); oth = shx(mx, lane, 32); }
            if (ks == 2) { mnew = max3f(mrun, mx, oth); alpha = __builtin_amdgcn_exp2f(mrun - mnew); mrun = mnew; PEXP(0); PEXP(1); }
            if (ks >= 3 && ks <= 9) { PEXP(2 + 4 * (ks - 3)); PEXP(3 + 4 * (ks - 3)); PEXP(4 + 4 * (ks - 3)); PEXP(5 + 4 * (ks - 3)); }
            if (ks == 10) { PEXP(30); PEXP(31); lrun = lrun * alpha + ps; }
            if (ks == 11) {
#pragma unroll
                for (int d = 0; d < 4; ++d) o[d] = o[d] * alpha; }
            __builtin_amdgcn_sched_barrier(0);
            ka0 = kn0; ka1 = kn1; kn0 = kf0; kn1 = kf1;
        }
#undef SEL
#undef PEXP
        bf16x8 pf[4];
#pragma unroll
        for (int s = 0; s < 2; ++s) {
            u32x4 p; p.x = cvtpk(s0[8 * s], s0[8 * s + 1]); p.y = cvtpk(s0[8 * s + 2], s0[8 * s + 3]); p.z = cvtpk(s0[8 * s + 4], s0[8 * s + 5]); p.w = cvtpk(s0[8 * s + 6], s0[8 * s + 7]);
            pf[s] = __builtin_bit_cast(bf16x8, p);
            u32x4 q; q.x = cvtpk(s1[8 * s], s1[8 * s + 1]); q.y = cvtpk(s1[8 * s + 2], s1[8 * s + 3]); q.z = cvtpk(s1[8 * s + 4], s1[8 * s + 5]); q.w = cvtpk(s1[8 * s + 6], s1[8 * s + 7]);
            pf[2 + s] = __builtin_bit_cast(bf16x8, q);
        }
        const LAS unsigned char* vb = lds + vsl * AV_BUF;
        bf16x8 va[4], vn[4];
#pragma unroll
        for (int d = 0; d < 4; ++d) va[d] = *(const LAS bf16x8*)(vb + d * 32 * AV_ROW + vco[0]);
#pragma unroll
        for (int j = 0; j < 4; ++j) {
#pragma unroll
            for (int d = 0; d < 4; ++d) vn[d] = (j < 3) ? *(const LAS bf16x8*)(vb + d * 32 * AV_ROW + vco[(j + 1) & 3]) : va[d];
#pragma unroll
            for (int d = 0; d < 4; ++d) o[d] = __builtin_amdgcn_mfma_f32_32x32x16_bf16(va[d], pf[j], o[d], 0, 0, 0);
            __builtin_amdgcn_sched_barrier(0);
#pragma unroll
            for (int d = 0; d < 4; ++d) va[d] = vn[d];
        }
        asm volatile("s_waitcnt lgkmcnt(0)" ::: "memory"); ATT_WAIT_V(5); ATT_BAR();
        s0 = n0; s1 = n1;
        ksl = (ksl + 1) & 3; vsl = vsl + 1 >= 3 ? 0 : vsl + 1;
    }
    ATT_WAIT_V(0); ATT_BAR();
    const float ltot = lrun + shx(lrun, lane, 32);
    const float inv = 1.0f / ltot;
    bf16_t* op = T.O + (size_t)(qrow0 + 32 * wid + r) * 1024 + h * 128 + 4 * h2;
#pragma unroll
    for (int d = 0; d < 4; ++d)
#pragma unroll
        for (int gq = 0; gq < 4; ++gq) {
            u32x2 w; w.x = cvtpk(o[d][4 * gq] * inv, o[d][4 * gq + 1] * inv); w.y = cvtpk(o[d][4 * gq + 2] * inv, o[d][4 * gq + 3] * inv);
            *(u32x2*)(op + 32 * d + 8 * gq) = w;
        }
#undef ATT_DMA_K
#undef ATT_DMA_V
#undef ATT_WAIT_V
#undef ATT_BAR
#undef ATT_KF
}

DI void transpose_item(const float* W, int N, bf16_t* WT, int ldt, int dst_row0, LAS float* scr, int k0, int n0, int lane_) {
    const int lane = opq(lane_);
    f32x4 v[8];
    const float* wp = W + (size_t)(k0 + (lane >> 3)) * N + n0 + (lane & 7) * 4;
#pragma unroll
    for (int i = 0; i < 8; ++i) v[i] = __builtin_nontemporal_load((const f32x4*)(wp + (size_t)(8 * i) * N));
#pragma unroll
    for (int i = 0; i < 8; ++i) { LAS float* s = scr + (8 * i + (lane >> 3)) * 33 + (lane & 7) * 4; s[0] = v[i][0]; s[1] = v[i][1]; s[2] = v[i][2]; s[3] = v[i][3]; }
    LDS_WAIT();
    const int c = lane & 7;
#pragma unroll
    for (int j = 0; j < 4; ++j) { const int n = (lane >> 3) + 8 * j; const LAS float* s = scr + (8 * c) * 33 + n;
        u32x4 o; o.x = cvtpk(s[0 * 33], s[1 * 33]); o.y = cvtpk(s[2 * 33], s[3 * 33]); o.z = cvtpk(s[4 * 33], s[5 * 33]); o.w = cvtpk(s[6 * 33], s[7 * 33]);
        *(u32x4*)(WT + (size_t)(dst_row0 + n) * ldt + k0 + 8 * c) = o; }
    LDS_WAIT();
}

DI void sincos2pi(double frac, float& cs, float& sn) {
    const double rr = frac - __builtin_rint(frac);
    const double x = rr * 6.283185307179586476925286766559, x2 = x * x;
    double c = 1.0, s = x, tc = 1.0, ts = x;
#pragma unroll 1
    for (int k = 1; k <= 14; ++k) { tc = -tc * x2 / (double)((2 * k - 1) * (2 * k)); ts = -ts * x2 / (double)((2 * k) * (2 * k + 1)); c += tc; s += ts; }
    cs = (float)c; sn = (float)s;
}

DI void first_norm(const float* xlo, const float* xhi, const float* g, const float* mod, bf16_t* H, float* SS, int gw, int ngw, int lane_) {
    const int lane = opq(lane_);
    for (int rb = gw; rb < NTOK / 8; rb += ngw) {
        const int row0 = rb * 8; const bool hi = row0 >= NCTX; const int cond = hi ? 1 + ((row0 - NCTX) >> 12) : 0;
        const float* mc = mod + cond * NMODC;
        f32x4 gs[4];
#pragma unroll
        for (int j = 0; j < 4; ++j) { const int col = 4 * lane + 256 * j; gs[j] = *(const f32x4*)(g + col) * (*(const f32x4*)(mc + 1024 + col) + 1.0f); }
#pragma unroll 2
        for (int i = 0; i < 8; ++i) {
            const int row = row0 + i;
            const float* xr = hi ? xhi + (size_t)(row - NCTX) * 1024 : xlo + (size_t)row * 1024;
            f32x4 v[4]; float ss = 0.f;
#pragma unroll
            for (int j = 0; j < 4; ++j) { v[j] = *(const f32x4*)(xr + 4 * lane + 256 * j); ss += (v[j].x * v[j].x + v[j].y * v[j].y) + (v[j].z * v[j].z + v[j].w * v[j].w); }
            ss = wave_sum(ss, lane);
            if (lane == 0) *(f32x4*)(SS + (size_t)row * 4) = (f32x4){ss, 0.f, 0.f, 0.f};
            bf16_t* hr = H + (size_t)row * 1024 + 4 * lane;
#pragma unroll
            for (int j = 0; j < 4; ++j) { const f32x4 y = v[j] * gs[j]; u32x2 w; w.x = cvtpk(y.x, y.y); w.y = cvtpk(y.z, y.w); *(u32x2*)(hr + 256 * j) = w; }
        }
    }
}
DI void shw_rows(const bf16_t* W, int nrows, const float* sh, float* out, int ostride, int gw, int ngw, int lane_) {
    const int lane = opq(lane_);
    f32x4 s[3][4];
#pragma unroll
    for (int c = 0; c < 3; ++c)
#pragma unroll
        for (int j = 0; j < 2; ++j) { s[c][2 * j] = *(const f32x4*)(sh + c * NMODC + 8 * lane + 512 * j); s[c][2 * j + 1] = *(const f32x4*)(sh + c * NMODC + 8 * lane + 512 * j + 4); }
    for (int n = gw; n < nrows; n += ngw) {
        const bf16_t* wr = W + (size_t)n * 1024 + 8 * lane;
        float a0 = 0.f, a1 = 0.f, a2 = 0.f;
#pragma unroll
        for (int j = 0; j < 2; ++j) { const bf16x8 w = *(const bf16x8*)(wr + 512 * j);
#pragma unroll
            for (int e = 0; e < 8; ++e) { const float wf = bf2f(w[e]); a0 += wf * s[0][2 * j + (e >> 2)][e & 3]; a1 += wf * s[1][2 * j + (e >> 2)][e & 3]; a2 += wf * s[2][2 * j + (e >> 2)][e & 3]; } }
        a0 = wave_sum(a0, lane); a1 = wave_sum(a1, lane); a2 = wave_sum(a2, lane);
        if (lane == 0) { out[n] = a0; out[ostride + n] = a1; out[2 * ostride + n] = a2; }
    }
}

#define XB_TMO      128
#define XB_XCNT(j)  (256  + 64 * (j))
#define XB_XSUB(j)  (1280 + 64 * (j))
#define XB_XGEN(j)  (2304 + 64 * (j))
#define XB_TOP      3328
#define XB_TOPGEN   3392
#define XCD_BAR_WORDS 3456
#define XB_SPIN_CAP (1u << 18)
static_assert(XCD_BAR_WORDS * 4 <= (int)BAR_BYTES, "barrier words inside the memset region");
DI unsigned xb_ld(unsigned* p)              { return __hip_atomic_load(p, __ATOMIC_RELAXED, __HIP_MEMORY_SCOPE_AGENT); }
DI unsigned xb_add(unsigned* p, unsigned v) { return __hip_atomic_fetch_add(p, v, __ATOMIC_RELAXED, __HIP_MEMORY_SCOPE_AGENT); }
DI unsigned xb_xcc_id() { return (unsigned)__builtin_amdgcn_s_getreg((3 << 11) | 20) & 0xFu; }
#define XB_SPIN(cond, bar) do { unsigned _sp = 0; while (cond) { __builtin_amdgcn_s_sleep(1); \
    if ((++_sp & 255u) == 0u) { if (xb_ld(&(bar)[XB_TMO])) break; if (_sp > XB_SPIN_CAP) { atomicAdd(&(bar)[XB_TMO], 1u); break; } } } } while (0)
struct XcdBarrier { unsigned* bar; unsigned x; volatile LAS unsigned* st; };
DI void xcd_barrier_complete(unsigned* bar, unsigned x, unsigned& nloc, unsigned& nx) {
    const unsigned G = gridDim.x * gridDim.y * gridDim.z;
    unsigned sum, cnt, mine, sp = 0u;
    for (;;) {
        sum = 0u; cnt = 0u; mine = 0u;
#pragma unroll
        for (unsigned j = 0; j < 16; ++j) { const unsigned c = xb_ld(&bar[XB_XCNT(j)]); sum += c; cnt += (c > 0u) ? 1u : 0u; mine = (j == x) ? c : mine; }
        if (sum == G) break;
        __builtin_amdgcn_s_sleep(1);
        if ((++sp & 255u) == 0u) { if (xb_ld(&bar[XB_TMO])) break; if (sp > XB_SPIN_CAP) { atomicAdd(&bar[XB_TMO], 1u); break; } }
    }
    nloc = mine > 0u ? mine : 1u; nx = cnt > 0u ? cnt : 1u;
}
DI void xcd_barrier(const XcdBarrier& b) {
    asm volatile("s_waitcnt vmcnt(0)" ::: "memory");
    __syncthreads();
    if (threadIdx.x == 0) {
        unsigned* bar = b.bar;
        __builtin_amdgcn_s_waitcnt(0);
        unsigned nloc = b.st[0], nx = b.st[1];
        if (nloc == 0u) { xcd_barrier_complete(bar, b.x, nloc, nx); b.st[0] = nloc; b.st[1] = nx; }
        const unsigned old = xb_add(&bar[XB_XSUB(b.x)], 1u);
        const unsigned gen = old / nloc;
        if (old + 1u == (gen + 1u) * nloc) {
            __builtin_amdgcn_fence(__ATOMIC_RELEASE, "agent");
            asm volatile("s_waitcnt vmcnt(0)" ::: "memory");
            const unsigned og = xb_add(&bar[XB_TOP], 1u);
            const unsigned tg = og / nx;
            if (og + 1u == (tg + 1u) * nx) xb_add(&bar[XB_TOPGEN], 1u);
            else XB_SPIN(xb_ld(&bar[XB_TOPGEN]) == tg, bar);
            __builtin_amdgcn_fence(__ATOMIC_ACQUIRE, "agent");
            xb_add(&bar[XB_XGEN(b.x)], 1u);
            asm volatile("s_waitcnt vmcnt(0)" ::: "memory");
        } else {
            XB_SPIN(xb_ld(&bar[XB_XGEN(b.x)]) == gen, bar);
            __builtin_amdgcn_fence(__ATOMIC_ACQUIRE, "agent");
            asm volatile("s_waitcnt vmcnt(0)" ::: "memory");
        }
    }
    __syncthreads();
}
#define GRID_BAR() do { XcdBarrier _b; _b.bar = (unsigned*)(kparams()->ws + WS_BAR); _b.x = xb_xcc_id(); _b.st = (volatile LAS unsigned*)(lds + LDS_MISC); xcd_barrier(_b); } while (0)

typedef const __attribute__((address_space(4))) Params* KP;
DI KP kparams() { KP p = (KP)__builtin_amdgcn_kernarg_segment_ptr(); asm volatile("" : "+s"(p)); return p; }
#define PH_ENTER const int tid = opq(threadIdx.x), lane = tid & 63, wave = __builtin_amdgcn_readfirstlane(tid >> 6); const int gw = vcu * 8 + wave; const int G = sopq(G0), ngw = G * 8; (void)ngw; \
    KP PP = kparams(); unsigned char* ws = PP->ws; unsigned char* mix = ws + WS_MIX; float* X = PP->out; (void)lane; (void)gw; (void)mix; (void)X; (void)tid;

__global__ void __launch_bounds__(512) mega_fwd(Params P_unused) {
    extern __shared__ __attribute__((aligned(16))) unsigned char lds_raw[];
    LAS unsigned char* lds = (LAS unsigned char*)lds_raw;
    cg::grid_group grid = cg::this_grid();
    const int G0 = gridDim.x, bx = blockIdx.x;
    const int vcu = (G0 % 8 == 0) ? (bx % 8) * (G0 / 8) + bx / 8 : bx;
    if (threadIdx.x < 2) ((volatile LAS unsigned*)(lds + LDS_MISC))[threadIdx.x] = 0u;
    __syncthreads();
    if (threadIdx.x == 0) (void)xb_add(&((unsigned*)(kparams()->ws + WS_BAR))[XB_XCNT(xb_xcc_id())], 1u);

    {
        PH_ENTER
        bf16_t* GU_T = (bf16_t*)(ws + WS_GU_T); bf16_t* D_T = (bf16_t*)(ws + WS_D_T); bf16_t* DQKV_T = (bf16_t*)(ws + WS_DQKV_T);
        bf16_t* UQ_T = (bf16_t*)(ws + WS_UQ_T); bf16_t* UK_T = (bf16_t*)(ws + WS_UK_T); bf16_t* UV_T = (bf16_t*)(ws + WS_UV_T);
        bf16_t* WO_T = (bf16_t*)(ws + WS_WO_T); bf16_t* FW_T = (bf16_t*)(ws + WS_FW_T);
        LAS float* scr = (LAS float*)(lds + wave * 8704);
        constexpr int NITEMS = 22528 + 11264 + 512 + 320 + 768 + 512 + 1024 + 1024;
        for (int rp = 0; rp < REP_PRO; ++rp) {
        for (int it = gw; it < NITEMS; it += ngw) {
            int r = it;
            if (r < 22528) { const int mtx = r / 1408, it2 = r % 1408, lf = mtx >> 1, gu = mtx & 1, kb = it2 / 88, n0 = (it2 % 88) * 32;
                transpose_item((gu ? PP->wu : PP->wg) + (size_t)lf * 1024 * DFF, DFF, GU_T + (size_t)lf * 5632 * 1024, 1024, (n0 >> 7) * 256 + gu * 128 + (n0 & 127), scr, kb * 64, n0, lane); continue; }
            r -= 22528;
            if (r < 11264) { const int mtx = r / 1408, it2 = r % 1408, kb = it2 / 32, n0 = (it2 % 32) * 32;
                transpose_item(PP->wd + (size_t)mtx * DFF * 1024, 1024, D_T + (size_t)mtx * 1024 * DFF, DFF, n0, scr, kb * 64, n0, lane); continue; }
            r -= 11264;
            if (r < 512) { const int j = r / 256, it2 = r % 256, kb = it2 / 16, n0 = (it2 % 16) * 32;
                transpose_item(PP->w_dq + (size_t)j * 1024 * 512, 512, DQKV_T + (size_t)j * 1024 * 1024, 1024, n0, scr, kb * 64, n0, lane); continue; }
            r -= 512;
            if (r < 320) { const int j = r / 160, it2 = r % 160, kb = it2 / 10, n0 = (it2 % 10) * 32;
                transpose_item(PP->w_dkv + (size_t)j * 1024 * 320, 320, DQKV_T + (size_t)j * 1024 * 1024, 1024, 512 + n0, scr, kb * 64, n0, lane); continue; }
            r -= 320;
            if (r < 768) { const int j = r / 384, it2 = r % 384, kb = it2 / 48, n0 = (it2 % 48) * 32;
                transpose_item(PP->w_uq + (size_t)j * 512 * 1536, 1536, UQ_T + (size_t)j * 1536 * 512, 512, n0, scr, kb * 64, n0, lane); continue; }
            r -= 768;
            if (r < 512) { const int j = r / 256, it2 = r % 256, kb = it2 / 64, n0 = (it2 % 64) * 32, hh = n0 >> 8, cc = n0 & 255;
                bf16_t* dst = (cc < 128 ? UK_T : UV_T) + (size_t)j * 1024 * 256;
                transpose_item(PP->w_ukv + (size_t)j * 256 * 2048, 2048, dst, 256, hh * 128 + (cc & 127), scr, kb * 64, n0, lane); continue; }
            r -= 512;
            if (r < 1024) { const int j = r / 512, it2 = r % 512, kb = it2 / 32, n0 = (it2 % 32) * 32;
                transpose_item(PP->w_o + (size_t)j * 1024 * 1024, 1024, WO_T + (size_t)j * 1024 * 1024, 1024, n0, scr, kb * 64, n0, lane); continue; }
            r -= 1024;
            { const int j = r / 512, it2 = r % 512, kb = it2 / 32, n0 = (it2 % 32) * 32;
                transpose_item(PP->fw + (size_t)j * 1024 * 1024, 1024, FW_T + (size_t)j * 1024 * 2048, 2048, n0, scr, kb * 64, n0, lane);
                transpose_item(PP->fw + (size_t)j * 1024 * 1024, 1024, FW_T + (size_t)j * 1024 * 2048 + 1024, 2048, n0, scr, kb * 64, n0, lane); }
        }
        float* PART = (float*)(mix + MX_MODPART);
        const float* c_ctx = PP->c_ctx; const float* cc = PP->c; const float* w_mod = PP->w_mod;
        for (int item = bx; item < 256; item += G) {
            const int l = item >> 6, kc = item & 63;
            f32x4 acc[3][5];
#pragma unroll
            for (int cnd = 0; cnd < 3; ++cnd)
#pragma unroll
                for (int jj = 0; jj < 5; ++jj) acc[cnd][jj] = (f32x4){0.f, 0.f, 0.f, 0.f};
            const bool has5 = tid < 256;
#pragma unroll 2
            for (int kk = 0; kk < 16; ++kk) {
                const int k = kc * 16 + kk;
                const float s0 = silu_f(c_ctx[k]), s1 = silu_f(cc[k]), s2 = silu_f(cc[1024 + k]);
                const float* wrow = w_mod + ((size_t)l * 1024 + k) * NMODC + 4 * tid;
#pragma unroll
                for (int jj = 0; jj < 5; ++jj) { if (jj < 4 || has5) { const f32x4 w = *(const f32x4*)(wrow + 2048 * jj); acc[0][jj] += w * s0; acc[1][jj] += w * s1; acc[2][jj] += w * s2; } }
            }
#pragma unroll
            for (int cnd = 0; cnd < 3; ++cnd)
#pragma unroll
                for (int jj = 0; jj < 5; ++jj) if (jj < 4 || has5) *(f32x4*)(PART + ((size_t)item * 3 + cnd) * NMODC + 4 * tid + 2048 * jj) = acc[cnd][jj];
        }
        }
        if (bx == G - 1) {
            float* ROPE = (float*)(ws + WS_ROPE); float* TAB = (float*)(ws + WS_TAB);
            for (int e = tid; e < 1024; e += 512) { const int idx = e >> 4, f = e & 15; double inv = 1.0; for (int q = 0; q < f; ++q) inv *= 0.56234132519034908;
                float cs, sn; sincos2pi((double)idx * inv * 0.15915494309189533577, cs, sn); ROPE[e] = cs; ROPE[1024 + e] = sn; }
            for (int e = tid; e < 4096; e += 512) { float cs, sn; sincos2pi((double)e * (1.0 / 4096.0), cs, sn); TAB[e] = cs; TAB[4096 + e] = sn; }
        }
    }
    grid.sync();
    {
        PH_ENTER
        const float* PART = (const float*)(mix + MX_MODPART); float* MOD = (float*)(ws + WS_MOD); const float* b_mod = PP->b_mod;
        for (int e = bx * 512 + tid; e < 4 * MODL; e += G * 512) {
            const int l = e / MODL, rem = e % MODL, n = rem % NMODC;
            float s = b_mod[l * NMODC + n];
#pragma unroll 8
            for (int kc = 0; kc < 64; ++kc) s += PART[(size_t)(l * 64 + kc) * MODL + rem];
            MOD[e] = s;
        }
        bf16_t* DSC = (bf16_t*)(ws + WS_DSC); bf16_t* DSS = (bf16_t*)(ws + WS_DSS); bf16_t* DC = (bf16_t*)(ws + WS_DC); bf16_t* CS = (bf16_t*)(ws + WS_CS); const float* TAB = (const float*)(ws + WS_TAB);
        for (int ch = bx * 512 + tid; ch < 4096 * (KFY / 8); ch += G * 512) {
            const int s = ch / (KFY / 8), c8 = ch % (KFY / 8); const bool sn = c8 >= KFC / 8; const int k0 = (sn ? c8 - KFC / 8 : c8) * 8;
            float v[8];
#pragma unroll
            for (int j = 0; j < 8; ++j) { const int k = k0 + j;
                if (!sn) v[j] = k <= 2048 ? TAB[(s * k) & 4095] * 0.015625f : 0.f;
                else v[j] = k <= 2046 ? -TAB[4096 + ((s * (k + 1)) & 4095)] * 0.015625f : 0.f; }
            u32x4 w; w.x = cvtpk(v[0], v[1]); w.y = cvtpk(v[2], v[3]); w.z = cvtpk(v[4], v[5]); w.w = cvtpk(v[6], v[7]);
            *(u32x4*)((sn ? DSS + (size_t)s * KFS : DSC + (size_t)s * KFC) + k0) = w;
        }
        for (int e = bx * 512 + tid; e < 256 * 512; e += G * 512) {
            const int s = e >> 9, k = e & 511; const bool sn = k >= 256; const int ix = ((s * (sn ? k - 256 : k)) & 255) * 16;
            DC[e] = f2bf(sn ? -TAB[4096 + ix] * 0.0625f : TAB[ix] * 0.0625f);
        }
        for (int e = bx * 512 + tid; e < 512 * 256; e += G * 512) {
            const int m = e >> 8, k = e & 255; const bool sn = m >= 256; const int ix = (((sn ? m - 256 : m) * k) & 255) * 16;
            CS[e] = f2bf(sn ? TAB[4096 + ix] * 0.0625f : TAB[ix] * 0.0625f);
        }
    }
    GRID_BAR();
    {
        PH_ENTER
        const float* MOD = (const float*)(ws + WS_MOD); const float* norm_g = PP->norm_g;
        float* GS = (float*)(ws + WS_GS);
        for (int e = bx * 512 + tid; e < 12 * 3 * 1024; e += G * 512) {
            const int p = e / 3072, rem = e % 3072, cnd = rem >> 10, col = rem & 1023, l = p / 3, sub = p % 3;
            GS[e] = norm_g[p * 1024 + col] * (1.0f + MOD[l * MODL + cnd * NMODC + (3 * sub + 1) * 1024 + col]);
        }
        for (int lf = 0; lf < 8; ++lf)
            shw_rows((const bf16_t*)(ws + WS_GU_T) + (size_t)lf * 5632 * 1024, 5632, MOD + (lf >> 1) * MODL + ((lf & 1) * 6) * 1024, (float*)(ws + WS_SHWGU) + (size_t)lf * 3 * 5632, 5632, gw, ngw, lane);
        for (int j = 0; j < 2; ++j)
            shw_rows((const bf16_t*)(ws + WS_DQKV_T) + (size_t)j * 1024 * 1024, 832, MOD + (2 * j) * MODL + 3 * 1024, (float*)(ws + WS_SHWDQ) + (size_t)j * 3 * 1024, 1024, gw, ngw, lane);
        { const bf16_t* CS = (const bf16_t*)(ws + WS_CS); float* SHC = (float*)(ws + WS_SHC);
          for (int e = bx * 512 + tid; e < 2 * 3 * 4 * 512; e += G * 512) {
              const int j = e / 6144, rem = e % 6144, cnd = rem / 2048, gq = (rem >> 9) & 3, m = rem & 511;
              const float* sh = MOD + (2 * j + 1) * MODL + cnd * NMODC + 3 * 1024 + gq * 256; const bf16_t* cr = CS + m * 256;
              float a = 0.f;
              for (int k = 0; k < 256; ++k) a += bf2f((short)cr[k]) * sh[k];
              SHC[e] = a;
          } }
        first_norm(PP->x_prompt, PP->x_sample, norm_g, MOD, (bf16_t*)(ws + WS_H), (float*)(ws + WS_SS), gw, ngw, lane);
    }
    GRID_BAR();

    for (int l = 0; l < 4; ++l) {
        for (int sub = 0; sub < 3; ++sub) {
#define XSRC const bool first = (l == 0 && sub == 0); const float* xlo = first ? PP->x_prompt : X; const float* xhi = first ? PP->x_sample : X + (size_t)NCTX * DM; \
             const float* modl = (const float*)(ws + WS_MOD) + l * MODL; const int jm = l >> 1; const int np = l * 3 + sub; const bool hn = np < 11; \
             const float* SSp = (const float*)(ws + WS_SS) + (size_t)np * NTOK * 4; float* SSn = (float*)(ws + WS_SS) + (size_t)(hn ? np + 1 : np) * NTOK * 4; const float* GSn = (const float*)(ws + WS_GS) + (size_t)(np + 1) * 3072; \
             bf16_t* Hn = (bf16_t*)(ws + WS_H); (void)jm; (void)modl; (void)xlo; (void)xhi; (void)SSp; (void)SSn; (void)GSn; (void)Hn;
            if (sub != 1) {
                {
                    PH_ENTER XSRC
                    const int lf = l * 2 + (sub >> 1);
                    pg8::Gemm g{(const bf16_t*)(ws + WS_H), (const bf16_t*)(ws + WS_GU_T) + (size_t)lf * 5632 * 1024, 1024, 1024, 1024, 64, 22, 1, 0, 0}; pg8::Order S; S.init(g, G, bx);
                    pg8::EpiSwiglu E{(bf16_t*)(mix + MX_ACT), SSp, (const float*)(ws + WS_SHWGU) + (size_t)lf * 3 * 5632}; for (int rp = 0; rp < REP_GU; ++rp) pg8::gemm_phase(lds, g, S, E);
                }
                GRID_BAR();
                {
                    PH_ENTER XSRC
                    const int lf = l * 2 + (sub >> 1);
                    pg8::Gemm g{(const bf16_t*)(mix + MX_ACT), (const bf16_t*)(ws + WS_D_T) + (size_t)lf * 1024 * DFF, DFF, DFF, DFF, 64, 4, 1, 0, 0}; pg8::Order S; S.init(g, G, bx);
                    pg8::EpiResid E{xlo, xhi, X, modl + (3 * sub + 2) * 1024, nullptr, Hn, GSn, SSn, lds, 0.5f, hn ? 1 : 0}; pg8::gemm_phase(lds, g, S, E);
                }
                GRID_BAR();
            } else {
                if ((l & 1) == 0) {
                    {
                        PH_ENTER XSRC
                        bf16_t* CQ = (bf16_t*)(mix + MX_CQ); bf16_t* CKV = (bf16_t*)(mix + MX_CKV); bf16_t* KPE = (bf16_t*)(mix + MX_KPE); float* SSKV = (float*)(mix + MX_SSKV);
                        float* NEW_CKV = X + (size_t)NTOK * DM; float* NEW_KPE = NEW_CKV + (size_t)32 * 2 * 256 * 256;
                        { const float* cache_ckv = PP->cache_ckv; const float* cache_kpe = PP->cache_kpe;
                          for (int cr = gw; cr < 1024; cr += ngw) { const int bb = cr >> 9, tt = cr & 511, kvrow = NCTX + bb * KVB + tt; const size_t crow = (size_t)((bb * 2 + jm) * 512 + tt);
                              const f32x4 cv = *(const f32x4*)(cache_ckv + crow * 256 + 4 * lane);
                              u32x2 w; w.x = cvtpk(cv.x, cv.y); w.y = cvtpk(cv.z, cv.w); *(u32x2*)(CKV + (size_t)kvrow * 256 + 4 * lane) = w;
                              if (lane < 16) { const f32x4 pv = *(const f32x4*)(cache_kpe + crow * 64 + 4 * lane); w.x = cvtpk(pv.x, pv.y); w.y = cvtpk(pv.z, pv.w); *(u32x2*)(KPE + (size_t)kvrow * 64 + 4 * lane) = w; }
                              if (lane == 0) SSKV[kvrow] = 256.0f * (1.0f - EPS); } }
                        pg8::Gemm g{(const bf16_t*)(ws + WS_H), (const bf16_t*)(ws + WS_DQKV_T) + (size_t)jm * 1024 * 1024, 1024, 1024, 1024, 64, 4, 1, 0, 0}; pg8::Order S; S.init(g, G, bx);
                        pg8::EpiDq E{CQ, CKV, KPE, NEW_CKV, NEW_KPE, (float*)(mix + MX_SSQ), SSKV, SSp, (const float*)(ws + WS_SHWDQ) + (size_t)jm * 3 * 1024,
                                     PP->q_norm + jm * 512, PP->kv_norm + jm * 256, (const float*)(ws + WS_ROPE), lds, jm};
                        pg8::gemm_phase(lds, g, S, E);
                    }
                    GRID_BAR();
                    for (int which = 0; which < 3; ++which) {
                        PH_ENTER
                        const int jm = l >> 1;
                        bf16_t* CQ = (bf16_t*)(mix + MX_CQ); bf16_t* CKV = (bf16_t*)(mix + MX_CKV);
                        pg8::Gemm g; pg8::EpiBf16 E; int rot;
                        if (which == 0) { g = pg8::Gemm{CQ, (const bf16_t*)(ws + WS_UQ_T) + (size_t)jm * 1536 * 512, 512, 512, 512, 64, 6, 1, 0, 0}; E = pg8::EpiBf16{(bf16_t*)(mix + MX_Q), 1536, 0, QSCALE, 0, 0, (const float*)(mix + MX_SSQ), 1}; rot = 0; }
                        else if (which == 1) { g = pg8::Gemm{CKV, (const bf16_t*)(ws + WS_UK_T) + (size_t)jm * 1024 * 256, 256, 256, 256, 68, 4, 1, 0, 0}; E = pg8::EpiBf16{(bf16_t*)(mix + MX_KN), 1024, 0, 1.0f, 0, 0, (const float*)(mix + MX_SSKV), 2}; rot = 384; }
                        else { g = pg8::Gemm{(const bf16_t*)(ws + WS_UV_T) + (size_t)jm * 1024 * 256, CKV, 256, 256, 256, 4, 68, 1, 0, 0}; E = pg8::EpiBf16{(bf16_t*)(mix + MX_VT), KVROWS, 0, 1.0f, 0, 0, (const float*)(mix + MX_SSKV), 3}; rot = 384 + 272; }
                        pg8::Order S; S.init(g, G, (bx + G - rot % G) % G);
                        pg8::gemm_phase(lds, g, S, E);
                        if (which == 2) {
                            float* NEW_CKV = X + (size_t)NTOK * DM; const float* SSKV = (const float*)(mix + MX_SSKV);
                            for (int e4 = bx * 512 + tid; e4 < NCTX * 64; e4 += G * 512) { const int row = e4 >> 6, c4 = e4 & 63;
                                float* p = NEW_CKV + ((size_t)((row >> 8) * 2 + jm) * 256 + (row & 255)) * 256 + 4 * c4;
                                *(f32x4*)p = *(const f32x4*)p * __builtin_amdgcn_rsqf(SSKV[row] * (1.0f / 256.0f) + EPS); }
                        }
                    }
                    GRID_BAR();
                    {
                        PH_ENTER
                        AttnT T{(const bf16_t*)(mix + MX_Q), (const bf16_t*)(mix + MX_KN), (const bf16_t*)(mix + MX_KPE), (const bf16_t*)(mix + MX_VT), (bf16_t*)(mix + MX_O), (const float*)(ws + WS_ROPE)};
                        for (int rp = 0; rp < REP_ATTN; ++rp) {
                        for (int u = vcu; u < 256; u += G) { const int bh = u >> 4, qb = u & 15, b = bh >> 3, hh = bh & 7;
                            attn_unit(lds, T, NCTX + b * 4096 + qb * 256, hh, NCTX + b * KVB, KVB, qb * 256, true); }
                        for (int u = vcu; u < 256; u += G) { const int b = u >> 3, hh = u & 7;
                            attn_unit(lds, T, b * 256, hh, b * 256, 256, 0, false); }
                        }
                    }
                    GRID_BAR();
                } else {
                    {
                        PH_ENTER XSRC
                        {
                            const bf16_t* Hs = (const bf16_t*)(ws + WS_H); bf16_t* HFC = (bf16_t*)(mix + MX_HFC); bf16_t* HFS = (bf16_t*)(mix + MX_HFS);
                            for (int rr = gw; rr < 2 * (KFC + KFS); rr += ngw) {
                                const int b = rr / (KFC + KFS), q = rr % (KFC + KFS); const bool sn = q >= KFC; const int kq = sn ? q - KFC : q;
                                const int k = sn ? kq + 1 : kq;
                                const bool valid = sn ? (kq <= 2046) : (kq <= 2048); const bool two = (k >= 1 && k <= 2047);
                                bf16_t* dst = (sn ? HFS + ((size_t)b * KFS + kq) * 1024 : HFC + ((size_t)b * KFC + kq) * 1024) + 16 * lane;
                                u32x4 w0 = (u32x4){0u, 0u, 0u, 0u}, w1 = w0;
                                if (valid) {
                                    const int r1 = NCTX + b * 4096 + k, r2 = NCTX + b * 4096 + (two ? 4096 - k : k);
                                    const float rs1 = rsq_p4(SSp + (size_t)r1 * 4), rs2 = two ? rsq_p4(SSp + (size_t)r2 * 4) : 0.f;
                                    const float sg = sn ? -1.f : 1.f;
                                    const float* shp = modl + (1 + b) * NMODC + 3 * 1024 + 16 * lane;
                                    const bf16x8 a0 = *(const bf16x8*)(Hs + (size_t)r1 * 1024 + 16 * lane), a1 = *(const bf16x8*)(Hs + (size_t)r1 * 1024 + 16 * lane + 8);
                                    const bf16x8 c0 = *(const bf16x8*)(Hs + (size_t)r2 * 1024 + 16 * lane), c1 = *(const bf16x8*)(Hs + (size_t)r2 * 1024 + 16 * lane + 8);
                                    float v[16];
#pragma unroll
                                    for (int j = 0; j < 8; ++j) { v[j] = rs1 * bf2f(a0[j]) + sg * rs2 * bf2f(c0[j]); v[8 + j] = rs1 * bf2f(a1[j]) + sg * rs2 * bf2f(c1[j]); }
                                    if (!sn) { const float m2 = two ? 2.f : 1.f;
#pragma unroll
                                        for (int j = 0; j < 16; ++j) v[j] += m2 * shp[j]; }
                                    w0.x = cvtpk(v[0], v[1]); w0.y = cvtpk(v[2], v[3]); w0.z = cvtpk(v[4], v[5]); w0.w = cvtpk(v[6], v[7]);
                                    w1.x = cvtpk(v[8], v[9]); w1.y = cvtpk(v[10], v[11]); w1.z = cvtpk(v[12], v[13]); w1.w = cvtpk(v[14], v[15]);
                                }
                                *(u32x4*)dst = w0; *(u32x4*)(dst + 8) = w1;
                            }
                        }
                        pg8::Gemm g{(const bf16_t*)(ws + WS_CS), (const bf16_t*)(ws + WS_H), 256, 1024, 256, 2, 32, 4, 0, 256}; pg8::Order S; S.init(g, G, bx);
                        pg8::EpiYt E{(bf16_t*)(mix + MX_YTC), (bf16_t*)(mix + MX_YTC), SSp, (const float*)(ws + WS_SHC) + (size_t)jm * 3 * 4 * 512}; pg8::gemm_phase(lds, g, S, E);
                    }
                    GRID_BAR();
                    for (int which = 0; which < 2; ++which) {
                        PH_ENTER
                        bf16_t* YF = (bf16_t*)(mix + MX_YF);
                        pg8::Gemm g; pg8::EpiBf16 E; int rot;
                        if (which == 0) { g = pg8::Gemm{(const bf16_t*)(ws + WS_CS), (const bf16_t*)(mix + MX_HFC), 256, 1024, 256, 1, KFC / 256, 8, 0, (long)KFC * 1024, 2, 0, 256};
                            E = pg8::EpiBf16{YF, KFY, (long)1024 * KFY, 1.0f, 2, (long)256 * KFY}; rot = 0; }
                        else { g = pg8::Gemm{(const bf16_t*)(ws + WS_CS) + 256 * 256, (const bf16_t*)(mix + MX_HFS), 256, 1024, 256, 1, KFS / 256, 8, 0, (long)KFS * 1024, 2, 0, 256};
                            E = pg8::EpiBf16{YF + KFC, KFY, (long)1024 * KFY, 1.0f, 2, (long)256 * KFY}; rot = 8 * (KFC / 256); }
                        pg8::Order S; S.init(g, G, (bx + G - rot % G) % G);
                        pg8::gemm_phase(lds, g, S, E);
                    }
                    GRID_BAR();
                    for (int which = 0; which < 3; ++which) {
                        PH_ENTER
                        bf16_t* F = (bf16_t*)(mix + MX_F); const bf16_t* YF = (const bf16_t*)(mix + MX_YF);
                        pg8::Gemm g; pg8::EpiBf16 E; int rot;
                        if (which == 0) { g = pg8::Gemm{(const bf16_t*)(ws + WS_DSC), YF, KFC, KFY, KFC, 16, 4, 2, 0, (long)1024 * KFY};
                            E = pg8::EpiBf16{F + (size_t)NCTX * 2048, 2048, (long)4096 * 2048, 1.0f}; rot = 0; }
                        else if (which == 1) { g = pg8::Gemm{(const bf16_t*)(ws + WS_DSS), YF + KFC, KFS, KFY, KFS, 16, 4, 2, 0, (long)1024 * KFY};
                            E = pg8::EpiBf16{F + (size_t)NCTX * 2048 + 1024, 2048, (long)4096 * 2048, 1.0f}; rot = 128; }
                        else { g = pg8::Gemm{(const bf16_t*)(ws + WS_DC), (const bf16_t*)(mix + MX_YTC), 512, 512, 256, 1, 4, 64, 0, (long)1024 * 512, 1, 256, 256};
                            E = pg8::EpiBf16{F, 2048, (long)256 * 2048, 1.0f, 1, 1024}; rot = 0; }
                        pg8::Order S; S.init(g, G, (bx + G - rot % G) % G);
                        pg8::gemm_phase(lds, g, S, E);
                    }
                    GRID_BAR();
                }
                {
                    PH_ENTER XSRC
                    const bool mla = (l & 1) == 0;
                    const bf16_t* mixA = (const bf16_t*)(mix + (mla ? MX_O : MX_F));
                    const bf16_t* mixW = (const bf16_t*)(ws + (mla ? WS_WO_T : WS_FW_T)) + (size_t)jm * 1024 * (mla ? 1024 : 2048); const int mixK = mla ? 1024 : 2048;
                    const float* mixBias = mla ? nullptr : PP->fb + jm * 1024;
                    pg8::Gemm g{mixA, mixW, mixK, mixK, mixK, 64, 4, 1, 0, 0}; pg8::Order S; S.init(g, G, bx);
                    pg8::EpiResid E{xlo, xhi, X, modl + 5 * 1024, mixBias, Hn, GSn, SSn, lds, 1.0f, hn ? 1 : 0}; pg8::gemm_phase(lds, g, S, E);
                }
                GRID_BAR();
            }
        }
    }
    {
        PH_ENTER
        const float* fn = PP->final_norm;
        for (int row = gw; row < NTOK; row += ngw) {
            float* xr = X + (size_t)row * 1024 + 4 * lane;
            f32x4 v[4]; float ss = 0.f;
#pragma unroll
            for (int j = 0; j < 4; ++j) { v[j] = *(const f32x4*)(xr + 256 * j); ss += (v[j].x * v[j].x + v[j].y * v[j].y) + (v[j].z * v[j].z + v[j].w * v[j].w); }
            const float rs = 1.0f / sqrtf(wave_sum(ss, lane) * (1.0f / 1024.0f) + EPS);
#pragma unroll
            for (int j = 0; j < 4; ++j) *(f32x4*)(xr + 256 * j) = v[j] * rs * *(const f32x4*)(fn + 4 * lane + 256 * j);
        }
    }
}

extern "C" void kernel_launch(void* const* d_in, const int* in_sizes, int n_in, void* d_out, int out_size, void* d_ws, size_t ws_size, hipStream_t stream) {
    static int grid_blocks = 0;
    if (grid_blocks == 0) {
        if (n_in != 22 || ws_size < WS_END) { fprintf(stderr, "kernel_launch: need 22 inputs and >= %zu bytes of workspace (got %d, %zu)\n", (size_t)WS_END, n_in, ws_size); grid_blocks = -1; return; }
        int dev = 0, cus = 0, per_cu = 0;
        hipGetDevice(&dev);
        hipDeviceGetAttribute(&cus, hipDeviceAttributeMultiprocessorCount, dev);
        hipFuncSetAttribute((const void*)mega_fwd, hipFuncAttributeMaxDynamicSharedMemorySize, LDS_BYTES);
        hipOccupancyMaxActiveBlocksPerMultiprocessor(&per_cu, (const void*)mega_fwd, 512, LDS_BYTES);
        if (per_cu < 1) { fprintf(stderr, "kernel_launch: occupancy query says %d blocks per CU\n", per_cu); per_cu = 1; }
        (void)hipGetLastError();
        grid_blocks = cus;
    }
    if (grid_blocks < 0) return;
    (void)hipMemsetAsync((char*)d_ws + WS_BAR, 0, BAR_BYTES, stream);
    Params p{};
    const float** pp = (const float**)&p;
    for (int i = 0; i < 22; ++i) pp[i] = (const float*)d_in[i];
    p.out = (float*)d_out; p.ws = (unsigned char*)d_ws;
    void* args[] = {&p};
    hipError_t e = hipLaunchCooperativeKernel((const void*)mega_fwd, dim3(grid_blocks), dim3(512), args, LDS_BYTES, stream);
    if (e != hipSuccess) fprintf(stderr, "cooperative launch failed: %s (grid %d)\n", hipGetErrorString(e), grid_blocks);
}
```
